# Optimizing an MI355X kernel written in HIP

```python
import math
import jax, jax.numpy as jnp
from jax import lax
import numpy as np

D_MODEL = 4096
BATCH = 2
SEQ = 4096
DEPTH = 2

HEAD_DIM = 128
N_SLOTS = D_MODEL // HEAD_DIM
A_HEADS = N_SLOTS // 8
B_HEADS = (N_SLOTS - 2 * A_HEADS) // 2
C_HEADS = N_SLOTS - 2 * A_HEADS - B_HEADS
A_VDIM = 2 * HEAD_DIM
A_WIDTH = A_HEADS * A_VDIM
B_WIDTH = B_HEADS * HEAD_DIM
C_WIDTH = C_HEADS * HEAD_DIM
MIX_WIDTH = A_WIDTH + B_WIDTH + C_WIDTH
IN_SPLITS = [A_WIDTH] * 3 + [B_WIDTH] * 3 + [C_WIDTH] * 3
IN_WIDTH = sum(IN_SPLITS)
D_FF = -(-8 * D_MODEL // (3 * 256)) * 256
GRID_W = 64
NA_ROWS_MAX = 8
NA_COLS = 16
Q_BLOCK = 128
DILATED_BRANCHES = ((128, 1), (512, 4), (2048, 16))
C_QBLOCK = 64
RMS_EPS = 1e-6

kernel_name = "hybrid_diff_natten_dilated_encoder"


def rmsnorm(x, g):
    xf = x.astype(jnp.float32)
    y = xf * lax.rsqrt(jnp.mean(xf * xf, axis=-1, keepdims=True) + RMS_EPS)
    return (y * g.astype(jnp.float32)).astype(x.dtype)


def alibi_slopes(n):
    return jnp.exp2(-8.0 * jnp.arange(1, n + 1, dtype=jnp.float32) / n)


def diff_attention(q, k, v, lam, slopes):
    b_, s_len, h_, _, d = q.shape
    scale = d ** -0.5
    qh = jnp.transpose(q, (0, 2, 3, 1, 4))
    kh = jnp.transpose(k, (0, 2, 3, 1, 4))
    vh = jnp.transpose(v, (0, 2, 1, 3))
    pos = jnp.arange(s_len)

    def block(i):
        start = i * Q_BLOCK
        qb = lax.dynamic_slice_in_dim(qh, start, Q_BLOCK, axis=3)
        s = jnp.einsum('bhmqd,bhmkd->bhmqk', qb, kh, preferred_element_type=jnp.float32) * scale
        qpos = start + jnp.arange(Q_BLOCK)
        dist = jnp.abs(qpos[:, None] - pos[None, :]).astype(jnp.float32)
        s = s - slopes[None, :, None, None, None] * dist
        p = jax.nn.softmax(s, axis=-1)
        pdiff = p[:, :, 0] - lam * p[:, :, 1]
        return jnp.einsum('bhqk,bhkv->bhqv', pdiff.astype(v.dtype), vh)

    out = lax.map(block, jnp.arange(s_len // Q_BLOCK))
    return jnp.transpose(out, (1, 0, 3, 2, 4)).reshape(b_, s_len, h_, v.shape[-1])


def neighborhood_attention(q, k, v, rpb):
    b_, s_len, h_, d = q.shape
    rows = s_len // GRID_W
    kh_ = min(NA_ROWS_MAX, rows)
    kw_ = NA_COLS
    scale = d ** -0.5

    def grid(t):
        return jnp.transpose(t.reshape(b_, rows, GRID_W, h_, d), (0, 3, 1, 2, 4))

    qg, kg, vg = grid(q), grid(k), grid(v)
    cols = jnp.arange(GRID_W)
    c_start = jnp.clip(cols - kw_ // 2, 0, GRID_W - kw_)
    col_mask = (cols[None, :] >= c_start[:, None]) & (cols[None, :] < c_start[:, None] + kw_)
    dc_idx = jnp.clip(cols[None, :] - cols[:, None] + NA_COLS - 1, 0, 2 * NA_COLS - 2)
    rpb_c = rpb[:, :, dc_idx]

    def row(r):
        r_start = jnp.clip(r - kh_ // 2, 0, rows - kh_)
        qr = lax.dynamic_index_in_dim(qg, r, axis=2, keepdims=False)
        kb = lax.dynamic_slice_in_dim(kg, r_start, kh_, axis=2)
        vb = lax.dynamic_slice_in_dim(vg, r_start, kh_, axis=2)
        s = jnp.einsum('bhcd,bhijd->bhcij', qr, kb, preferred_element_type=jnp.float32) * scale
        dr_idx = r_start + jnp.arange(kh_) - r + NA_ROWS_MAX - 1
        bias = jnp.transpose(rpb_c[:, dr_idx], (0, 2, 1, 3)).astype(jnp.float32)
        s = jnp.where(col_mask[:, None, :], s + bias[None], -jnp.inf)
        p = jax.nn.softmax(s.reshape(b_, h_, GRID_W, kh_ * GRID_W), axis=-1)
        return jnp.einsum('bhcn,bhnd->bhcd', p.astype(v.dtype), vb.reshape(b_, h_, kh_ * GRID_W, d))

    out = lax.map(row, jnp.arange(rows))
    return jnp.transpose(out, (1, 0, 3, 2, 4)).reshape(b_, s_len, h_, d)


def dilated_attention(q, k, v, slopes):
    b_, s_len, h_, d = q.shape
    scale = d ** -0.5
    qh, kh, vh = [jnp.transpose(t, (0, 2, 1, 3)) for t in (q, k, v)]
    outs, lses = [], []
    for window, dil in DILATED_BRANCHES:
        radius = window // (2 * dil)
        L = s_len // dil
        qb_size = math.gcd(L, C_QBLOCK)
        n_blk = L // qb_size
        qs = jnp.transpose(qh.reshape(b_, h_, L, dil, d), (0, 1, 3, 2, 4)).reshape(b_, h_, dil, n_blk, qb_size, d)
        ks = jnp.transpose(kh.reshape(b_, h_, L, dil, d), (0, 1, 3, 2, 4))
        vs = jnp.transpose(vh.reshape(b_, h_, L, dil, d), (0, 1, 3, 2, 4))
        u_q = jnp.arange(n_blk)[:, None] * qb_size + jnp.arange(qb_size)[None, :]
        u_k = jnp.arange(n_blk)[:, None] * qb_size - radius + jnp.arange(qb_size + 2 * radius)[None, :]
        valid = (u_k >= 0) & (u_k < L)
        u_kc = jnp.clip(u_k, 0, L - 1)
        kb = jnp.take(ks, u_kc, axis=3)
        vb = jnp.take(vs, u_kc, axis=3)
        s = jnp.einsum('bhrnqd,bhrnkd->bhrnqk', qs, kb, preferred_element_type=jnp.float32) * scale
        du = jnp.abs(u_k[:, None, :] - u_q[:, :, None])
        mask = valid[:, None, :] & (du <= radius)
        s = s - slopes[None, :, None, None, None, None] * (du * dil).astype(jnp.float32)
        s = jnp.where(mask, s, -jnp.inf)
        lse = jax.nn.logsumexp(s, axis=-1)
        p = jnp.exp(s - lse[..., None])
        o = jnp.einsum('bhrnqk,bhrnkd->bhrnqd', p.astype(v.dtype), vb)
        o = jnp.transpose(o.reshape(b_, h_, dil, L, d), (0, 1, 3, 2, 4)).reshape(b_, h_, s_len, d)
        lse = jnp.transpose(lse.reshape(b_, h_, dil, L), (0, 1, 3, 2)).reshape(b_, h_, s_len)
        outs.append(o)
        lses.append(lse)
    w = jax.nn.softmax(jnp.stack(lses, axis=0), axis=0)
    out = jnp.einsum('gbhs,gbhsd->bhsd', w.astype(v.dtype), jnp.stack(outs, axis=0))
    return jnp.transpose(out, (0, 2, 1, 3))


def setup_inputs(seed: int = 0) -> dict:
    key = jax.random.key(seed)
    ks = jax.random.split(key, 24)
    f32 = jnp.float32

    def normal(k, shape, scale):
        return jax.random.normal(k, shape, dtype=f32) * scale

    def gain(k, shape):
        return 1.0 + 0.02 * jax.random.normal(k, shape, dtype=f32)

    n_rel_r = 2 * NA_ROWS_MAX - 1
    n_rel_c = 2 * NA_COLS - 1
    return {
        "x": normal(ks[0], (BATCH, SEQ, D_MODEL), 1.0),
        "norm1_g": gain(ks[1], (DEPTH, D_MODEL)),
        "w_in": normal(ks[2], (DEPTH, D_MODEL, IN_WIDTH), D_MODEL ** -0.5),
        "a_q_g": gain(ks[3], (DEPTH, HEAD_DIM)),
        "a_k_g": gain(ks[4], (DEPTH, HEAD_DIM)),
        "lambda_q1": normal(ks[5], (DEPTH, HEAD_DIM), 0.1),
        "lambda_k1": normal(ks[6], (DEPTH, HEAD_DIM), 0.1),
        "lambda_q2": normal(ks[7], (DEPTH, HEAD_DIM), 0.1),
        "lambda_k2": normal(ks[8], (DEPTH, HEAD_DIM), 0.1),
        "a_out_g": gain(ks[9], (DEPTH, A_VDIM)),
        "b_q_g": gain(ks[10], (DEPTH, HEAD_DIM)),
        "b_k_g": gain(ks[11], (DEPTH, HEAD_DIM)),
        "b_rpb": normal(ks[12], (DEPTH, B_HEADS, n_rel_r, n_rel_c), 0.02),
        "b_out_g": gain(ks[13], (DEPTH, HEAD_DIM)),
        "c_q_g": gain(ks[14], (DEPTH, HEAD_DIM)),
        "c_k_g": gain(ks[15], (DEPTH, HEAD_DIM)),
        "c_out_g": gain(ks[16], (DEPTH, HEAD_DIM)),
        "w_out": normal(ks[17], (DEPTH, MIX_WIDTH, D_MODEL), MIX_WIDTH ** -0.5),
        "norm2_g": gain(ks[18], (DEPTH, D_MODEL)),
        "w_gate": normal(ks[19], (DEPTH, D_MODEL, D_FF), D_MODEL ** -0.5),
        "w_up": normal(ks[20], (DEPTH, D_MODEL, D_FF), D_MODEL ** -0.5),
        "w_down": normal(ks[21], (DEPTH, D_FF, D_MODEL), D_FF ** -0.5),
    }


def reference(x, norm1_g, w_in, a_q_g, a_k_g, lambda_q1, lambda_k1, lambda_q2, lambda_k2, a_out_g,
              b_q_g, b_k_g, b_rpb, b_out_g, c_q_g, c_k_g, c_out_g, w_out, norm2_g, w_gate, w_up, w_down):
    b_, s_len, _ = x.shape
    slopes_a = alibi_slopes(A_HEADS)
    slopes_c = alibi_slopes(C_HEADS)
    split_points = [int(p) for p in np.cumsum(IN_SPLITS)[:-1]]
    for l in range(DEPTH):
        h = rmsnorm(x, norm1_g[l])
        proj = h @ w_in[l]
        qa, ka, va, qb, kb, vb, qc, kc, vc = jnp.split(proj, split_points, axis=-1)

        qa = rmsnorm(qa.reshape(b_, s_len, A_HEADS, 2, HEAD_DIM), a_q_g[l])
        ka = rmsnorm(ka.reshape(b_, s_len, A_HEADS, 2, HEAD_DIM), a_k_g[l])
        va = va.reshape(b_, s_len, A_HEADS, A_VDIM)
        lam_init = 0.8 - 0.6 * math.exp(-0.3 * l)
        lam = (jnp.exp(jnp.sum(lambda_q1[l].astype(jnp.float32) * lambda_k1[l].astype(jnp.float32)))
               - jnp.exp(jnp.sum(lambda_q2[l].astype(jnp.float32) * lambda_k2[l].astype(jnp.float32)))
               + lam_init)
        oa = diff_attention(qa, ka, va, lam, slopes_a)
        oa = rmsnorm(oa, a_out_g[l]) * (1.0 - lam_init)

        qb = rmsnorm(qb.reshape(b_, s_len, B_HEADS, HEAD_DIM), b_q_g[l])
        kb = rmsnorm(kb.reshape(b_, s_len, B_HEADS, HEAD_DIM), b_k_g[l])
        vb = vb.reshape(b_, s_len, B_HEADS, HEAD_DIM)
        ob = rmsnorm(neighborhood_attention(qb, kb, vb, b_rpb[l]), b_out_g[l])

        qc = rmsnorm(qc.reshape(b_, s_len, C_HEADS, HEAD_DIM), c_q_g[l])
        kc = rmsnorm(kc.reshape(b_, s_len, C_HEADS, HEAD_DIM), c_k_g[l])
        vc = vc.reshape(b_, s_len, C_HEADS, HEAD_DIM)
        oc = rmsnorm(dilated_attention(qc, kc, vc, slopes_c), c_out_g[l])

        mix = jnp.concatenate([oa.reshape(b_, s_len, A_WIDTH),
                               ob.reshape(b_, s_len, B_WIDTH),
                               oc.reshape(b_, s_len, C_WIDTH)], axis=-1)
        x = x + mix @ w_out[l]

        h2 = rmsnorm(x, norm2_g[l])
        x = x + (jax.nn.silu(h2 @ w_gate[l]) * (h2 @ w_up[l])) @ w_down[l]
    return x
```

```cpp
#include <hip/hip_runtime.h>
#include <cstdio>
#include <cstdint>
namespace pg8 {
#define PG8_LAS __attribute__((address_space(3)))
typedef unsigned short bf16_t;
typedef short bf16x8 __attribute__((ext_vector_type(8)));
typedef float f32x4 __attribute__((ext_vector_type(4)));
typedef unsigned u32x4 __attribute__((ext_vector_type(4)));
constexpr int BM = 256, BK = 64, HALF = 128, HTB = HALF * BK * 2  , STAGE_BYTES = 8 * HTB, NXCD = 8, WGM = 8;

__host__ __device__ __forceinline__ int lds_byte(int r, int c) { const int st = (r >> 4) * 2 + (c >> 5), rr = r & 15, cc = c & 31, ob = rr * 64 + cc * 2; return st * 1024 + (ob ^ (((ob >> 9) & 1) << 5)); }
__host__ __device__ __forceinline__ void stage_rc(int b, int& R, int& C) { const int st = b / 1024, sb = b % 1024, swz = sb ^ (((sb >> 9) & 1) << 5); R = (st >> 1) * 16 + swz / 64; C = (st & 1) * 32 + (swz % 64) / 2; }
__host__ __device__ __forceinline__ int perm32(int rho) { const int n = rho >> 4, i = rho & 15; return 8 * (i >> 2) + 4 * n + (i & 3); }

struct Unit { int pm, pn; };
struct Gemm { const bf16_t* A; const bf16_t* Bt; int M, N, K; int nt8 = 0; };

struct StaticOrder {
    int nM, nN, nwg, G, c;
    __host__ __device__ void init(int M, int N, int G_, int c_) { nM = M / BM; nN = N / BM; nwg = nM * nN; G = G_; c = c_; }
    __host__ __device__ __forceinline__ bool next(int i, Unit& u) const {
        const long L = (long)i * G + c; if (L >= nwg) return false;
        int wgid = (int)L; { const int q = nwg / NXCD, r = nwg % NXCD, xcd = wgid % NXCD, off = wgid / NXCD; wgid = (xcd < r ? xcd * (q + 1) : r * (q + 1) + (xcd - r) * q) + off; }
        const int nig = WGM * nN, gid = wgid / nig, fm = gid * WGM, gsz = (nM - fm) < WGM ? (nM - fm) : WGM;
        u.pm = fm + ((wgid % nig) % gsz); u.pn = (wgid % nig) / gsz; return true;
    }
    __device__ __forceinline__ void a_ready(const Unit&) const {}
    __device__ __forceinline__ void done(const Unit&) const {}
};

__device__ __forceinline__ unsigned cvt_pk_bf16(float lo, float hi) { unsigned r; asm volatile("v_cvt_pk_bf16_f32 %0, %1, %2" : "=v"(r) : "v"(lo), "v"(hi)); return r; }
typedef float f32x2 __attribute__((ext_vector_type(2)));
struct RowScale {
    const PG8_LAS float* rstab; int tab_pm; const float* ps; int np;
    __device__ __forceinline__ float get(int pm, int r, int row) const {
        if (pm == tab_pm) return rstab[r];
        float lo = 0.f, hi = 0.f; const int h = np > 1 ? np / 2 : 1;
        for (int i = 0; i < h; ++i) lo += ps[(size_t)row * np + i];
        if (np > 1) for (int i = 0; i < h; ++i) hi += ps[(size_t)row * np + h + i];
        return __builtin_amdgcn_rsqf((lo + hi) * (1.0f / 4096.0f) + 1e-6f);
    }
};
struct EpiProj {
    static constexpr bool PERM = true, AFTER_DRAIN = false;
    bf16_t* O; int ldc; RowScale rsc; const float *gqa, *gka, *gqb, *gkb, *gqc, *gkc; float qscale; PG8_LAS float* X;
    __device__ __forceinline__ void operator()(f32x4 (&acc)[2][2][4][2], const Unit& u, int wr, int wc, int fr, int fq) const {
        const int row0 = u.pm * BM + wr * 64 + fr, col0 = u.pn * BM + wc * 32 + 8 * fq, colt = u.pn * BM;
        const int reg = colt < 3072 ? colt / 1024 : colt < 7680 ? 3 + (colt - 3072) / 1536 : 6 + (colt - 7680) / 1536;
        const bool isv = (reg % 3) == 2, isq = (reg % 3) == 0;
#pragma unroll
        for (int ai = 0; ai < 2; ++ai)
#pragma unroll
            for (int m = 0; m < 4; ++m) { const float rs = rsc.get(u.pm, wr * 64 + fr + ai * HALF + m * 16, row0 + ai * HALF + m * 16);
#pragma unroll
                for (int bj = 0; bj < 2; ++bj) { acc[ai][bj][m][0] *= rs; acc[ai][bj][m][1] *= rs; } }
        if (!isv) {
            float sq[2][4][2];
#pragma unroll
            for (int ai = 0; ai < 2; ++ai)
#pragma unroll
                for (int m = 0; m < 4; ++m)
#pragma unroll
                    for (int bj = 0; bj < 2; ++bj) { const f32x4 a = acc[ai][bj][m][0], b = acc[ai][bj][m][1];
                        float s = (a[0] * a[0] + a[1] * a[1]) + (a[2] * a[2] + a[3] * a[3]) + (b[0] * b[0] + b[1] * b[1]) + (b[2] * b[2] + b[3] * b[3]);
                        s += __int_as_float(__builtin_amdgcn_ds_swizzle(__float_as_int(s), 0x1f | (16 << 10)));
                        auto rr = __builtin_amdgcn_permlane32_swap(__float_as_uint(s), __float_as_uint(s), false, false); sq[ai][m][bj] = __uint_as_float(rr[0]) + __uint_as_float(rr[1]); }
            if (fq == 0) {
#pragma unroll
                for (int ai = 0; ai < 2; ++ai)
#pragma unroll
                    for (int m = 0; m < 4; ++m)
#pragma unroll
                        for (int bj = 0; bj < 2; ++bj) X[(((((wr * 2 + ai) * 4 + m) * 16 + fr) * 2 + bj) * 4) + wc] = sq[ai][m][bj]; }
            asm volatile("s_waitcnt lgkmcnt(0)" ::: "memory"); __builtin_amdgcn_s_barrier(); asm volatile("" ::: "memory");
            const float* gsel = reg == 0 ? gqa : reg == 1 ? gka : reg == 3 ? gqb : reg == 4 ? gkb : reg == 6 ? gqc : gkc;
            const float* gp = gsel + wc * 32 + 8 * fq;
            const f32x4 g0 = *(const f32x4*)gp, g1 = *(const f32x4*)(gp + 4);
            const float qs = isq ? qscale : 1.0f;
#pragma unroll
            for (int ai = 0; ai < 2; ++ai)
#pragma unroll
                for (int m = 0; m < 4; ++m)
#pragma unroll
                    for (int bj = 0; bj < 2; ++bj) { const f32x4 t = *(const PG8_LAS f32x4*)(X + (((((wr * 2 + ai) * 4 + m) * 16 + fr) * 2 + bj) * 4));
                        const float r = __builtin_amdgcn_rsqf(((t[0] + t[1]) + (t[2] + t[3])) * (1.0f / 128.0f) + 1e-6f) * qs;
                        acc[ai][bj][m][0] = acc[ai][bj][m][0] * r * g0; acc[ai][bj][m][1] = acc[ai][bj][m][1] * r * g1; }
        }
#pragma unroll
        for (int ai = 0; ai < 2; ++ai)
#pragma unroll
            for (int m = 0; m < 4; ++m) { bf16_t* rowp = O + (size_t)(row0 + ai * HALF + m * 16) * ldc + col0;
#pragma unroll
                for (int bj = 0; bj < 2; ++bj) { const f32x4 v0 = acc[ai][bj][m][0], v1 = acc[ai][bj][m][1];
                    u32x4 w; w.x = cvt_pk_bf16(v0[0], v0[1]); w.y = cvt_pk_bf16(v0[2], v0[3]); w.z = cvt_pk_bf16(v1[0], v1[1]); w.w = cvt_pk_bf16(v1[2], v1[3]);
                    *(u32x4*)(rowp + bj * HALF) = w; } }
    }
};
__device__ __forceinline__ float silu_mul(float g, float u) { return g * __builtin_amdgcn_rcpf(1.0f + __builtin_amdgcn_exp2f(g * -1.4426950408889634f)) * u; }
template <int F8OUT> struct EpiSwiGLU {
    static constexpr bool PERM = true, AFTER_DRAIN = false;
    bf16_t* O; int ldb, k8; RowScale rsc;
    __device__ __forceinline__ void operator()(const f32x4 (&acc)[2][2][4][2], const Unit& u, int wr, int wc, int fr, int fq) const {
        const int row0 = u.pm * BM + wr * 64 + fr, col0 = u.pn * HALF + wc * 32 + 8 * fq;
        const bool f8 = F8OUT == 1 || (F8OUT == 2 && u.pn * HALF < k8);
#pragma unroll
        for (int ai = 0; ai < 2; ++ai)
#pragma unroll
            for (int m = 0; m < 4; ++m) { unsigned char* rp = (unsigned char*)O + (size_t)(row0 + ai * HALF + m * 16) * ldb;
                const float rs = rsc.get(u.pm, wr * 64 + fr + ai * HALF + m * 16, row0 + ai * HALF + m * 16);
                const f32x4 g0 = acc[ai][0][m][0] * rs, g1 = acc[ai][0][m][1] * rs, u0 = acc[ai][1][m][0] * rs, u1 = acc[ai][1][m][1] * rs;
                const float s0 = silu_mul(g0[0], u0[0]), s1 = silu_mul(g0[1], u0[1]), s2 = silu_mul(g0[2], u0[2]), s3 = silu_mul(g0[3], u0[3]);
                const float s4 = silu_mul(g1[0], u1[0]), s5 = silu_mul(g1[1], u1[1]), s6 = silu_mul(g1[2], u1[2]), s7 = silu_mul(g1[3], u1[3]);
                if (f8) {
                    unsigned w0 = 0u, w1 = 0u;
#define F8V(x) __builtin_amdgcn_fmed3f(16.f * (x), -448.f, 448.f)
                    w0 = __builtin_amdgcn_cvt_pk_fp8_f32(F8V(s0), F8V(s1), w0, false); w0 = __builtin_amdgcn_cvt_pk_fp8_f32(F8V(s2), F8V(s3), w0, true);
                    w1 = __builtin_amdgcn_cvt_pk_fp8_f32(F8V(s4), F8V(s5), w1, false); w1 = __builtin_amdgcn_cvt_pk_fp8_f32(F8V(s6), F8V(s7), w1, true);
#undef F8V
                    typedef unsigned u32x2_ __attribute__((ext_vector_type(2))); *(u32x2_*)(rp + col0) = (u32x2_){w0, w1};
                } else {
                    u32x4 w; w.x = cvt_pk_bf16(s0, s1); w.y = cvt_pk_bf16(s2, s3); w.z = cvt_pk_bf16(s4, s5); w.w = cvt_pk_bf16(s6, s7);
                    *(u32x4*)(rp + k8 + (col0 - k8) * 2) = w; } }
    }
};
__device__ __forceinline__ float bf_lo(unsigned w) { return __uint_as_float(w << 16); }
__device__ __forceinline__ float bf_hi(unsigned w) { return __uint_as_float(w & 0xffff0000u); }
template <bool FINAL, int XMP = 0, int XK8 = 0> struct EpiRes {
    static constexpr bool PERM = true, AFTER_DRAIN = false;
    const bf16_t* base; bf16_t* out; float* outf;
    unsigned char* xm;
    int ldc; float* ps; float ascale;
    __device__ __forceinline__ void operator()(const f32x4 (&acc)[2][2][4][2], const Unit& u, int wr, int wc, int fr, int fq) const {
        int frl = fr, fql = fq; asm volatile("" : "+v"(frl), "+v"(fql));
        const int row0 = u.pm * BM + wr * 64 + frl, col0 = u.pn * BM + wc * 32 + 8 * fql;
        u32x4 bv[2][4][2];
#pragma unroll
        for (int ai = 0; ai < 2; ++ai)
#pragma unroll
            for (int m = 0; m < 4; ++m)
#pragma unroll
                for (int bj = 0; bj < 2; ++bj) bv[ai][m][bj] = *(const u32x4*)(base + (size_t)(row0 + ai * HALF + m * 16) * ldc + col0 + bj * HALF);
#pragma unroll
        for (int ai = 0; ai < 2; ++ai)
#pragma unroll
            for (int m = 0; m < 4; ++m) { const int row = row0 + ai * HALF + m * 16; const size_t off = (size_t)row * ldc + col0; float sp = 0.f;
#pragma unroll
                for (int bj = 0; bj < 2; ++bj) { const u32x4 b = bv[ai][m][bj];
                    const f32x4 v0 = (f32x4){bf_lo(b.x), bf_hi(b.x), bf_lo(b.y), bf_hi(b.y)} + acc[ai][bj][m][0] * ascale, v1 = (f32x4){bf_lo(b.z), bf_hi(b.z), bf_lo(b.w), bf_hi(b.w)} + acc[ai][bj][m][1] * ascale;
                    if constexpr (FINAL) { *(f32x4*)(outf + off + bj * HALF) = v0; *(f32x4*)(outf + off + bj * HALF + 4) = v1; }
                    else { sp += (v0[0] * v0[0] + v0[1] * v0[1]) + (v0[2] * v0[2] + v0[3] * v0[3]) + (v1[0] * v1[0] + v1[1] * v1[1]) + (v1[2] * v1[2] + v1[3] * v1[3]);
                        u32x4 w; w.x = cvt_pk_bf16(v0[0], v0[1]); w.y = cvt_pk_bf16(v0[2], v0[3]); w.z = cvt_pk_bf16(v1[0], v1[1]); w.w = cvt_pk_bf16(v1[2], v1[3]);
                        *(u32x4*)(out + off + bj * HALF) = w;
                        if constexpr (XMP > 0) { unsigned char* xr = xm + (size_t)row * XMP; const int c = col0 + bj * HALF;
                            if (u.pn * BM < XK8) { unsigned w0 = 0u, w1 = 0u;
#define F8V(x) __builtin_amdgcn_fmed3f(16.f * (x), -448.f, 448.f)
                                w0 = __builtin_amdgcn_cvt_pk_fp8_f32(F8V(v0[0]), F8V(v0[1]), w0, false); w0 = __builtin_amdgcn_cvt_pk_fp8_f32(F8V(v0[2]), F8V(v0[3]), w0, true);
                                w1 = __builtin_amdgcn_cvt_pk_fp8_f32(F8V(v1[0]), F8V(v1[1]), w1, false); w1 = __builtin_amdgcn_cvt_pk_fp8_f32(F8V(v1[2]), F8V(v1[3]), w1, true);
#undef F8V
                                typedef unsigned u32x2_ __attribute__((ext_vector_type(2))); *(u32x2_*)(xr + c) = (u32x2_){w0, w1}; }
                            else *(u32x4*)(xr + XK8 + (c - XK8) * 2) = w; } } }
                if constexpr (!FINAL) { sp += __int_as_float(__builtin_amdgcn_ds_swizzle(__float_as_int(sp), 0x1f | (16 << 10)));
                    auto rr = __builtin_amdgcn_permlane32_swap(__float_as_uint(sp), __float_as_uint(sp), false, false); sp = __uint_as_float(rr[0]) + __uint_as_float(rr[1]);
                    if (fql == 0) ps[(size_t)row * 64 + u.pn * 4 + wc] = sp; } }
    }
};
typedef int pg8_i32x8 __attribute__((ext_vector_type(8))); typedef int pg8_i32x4 __attribute__((ext_vector_type(4)));
__device__ __forceinline__ pg8_i32x8 pg8_cat(bf16x8 a, bf16x8 b) { const pg8_i32x4 x = __builtin_bit_cast(pg8_i32x4, a), y = __builtin_bit_cast(pg8_i32x4, b); return __builtin_shufflevector(x, y, 0, 1, 2, 3, 4, 5, 6, 7); }
template <class Epi, class Sched, bool ALIGN_EPI = false, bool SP2 = false, int FP8 = 0>
__device__ __forceinline__ void gemm_phase(PG8_LAS unsigned char* lds, const Gemm g, const Sched& S, const Epi& E) {
    int tid_ = threadIdx.x; asm volatile("" : "+v"(tid_));
    const int tid = tid_, wid = __builtin_amdgcn_readfirstlane(tid >> 6), lane = tid & 63, wr = wid >> 2, wc = wid & 3, fr = lane & 15, fq = lane >> 4;
    const int K = g.K, nt = K / BK;
    unsigned voffA[2], voffB[2];
#pragma unroll
    for (int i = 0; i < 2; ++i) { int R, C; stage_rc(tid * 16 + i * 8192, R, C); const int Rb = Epi::PERM ? ((R & ~31) + perm32(R & 31)) : R;
        voffA[i] = (unsigned)(R * K + C) * 2u; voffB[i] = (unsigned)(Rb * K + C) * 2u; }
    const size_t kstep = (size_t)(BK * 2);
    const size_t hstep = (size_t)HALF * K * 2;
    const size_t tstep = 2 * hstep;
    const unsigned ldsw = (unsigned)wid * 1024u;
    const int aoff = lds_byte(wr * 64 + fr, fq * 8), boff = lds_byte(wc * 32 + fr, fq * 8);
#define PG8_SA(b, h) (((b) * 2 + (h)) * HTB)
#define PG8_SB(b, h) ((4 + (b) * 2 + (h)) * HTB)
#define PG8_STAGE(bufoff, gbase, voff) do { _Pragma("unroll") for (int _i = 0; _i < 2; ++_i) \
        __builtin_amdgcn_global_load_lds((const unsigned*)((const char*)(gbase) + (voff)[_i]), (PG8_LAS unsigned*)(lds + (bufoff) + ldsw + _i * 8192), 16, 0, 0); } while (0)
#define PG8_LDA(dst, b, h) do { if constexpr (FP8_) { _Pragma("unroll") for (int m = 0; m < 4; ++m) { const pg8_i32x4 lo_ = *(const PG8_LAS pg8_i32x4*)(lds + PG8_SA(b, h) + aoff + m * 2048), hi_ = *(const PG8_LAS pg8_i32x4*)(lds + PG8_SA(b, h) + aoff + m * 2048 + 1024); dst##8[m] = __builtin_shufflevector(lo_, hi_, 0, 1, 2, 3, 4, 5, 6, 7); } } \
        else { _Pragma("unroll") for (int m = 0; m < 4; ++m) _Pragma("unroll") for (int k = 0; k < 2; ++k) dst[m][k] = *(const PG8_LAS bf16x8*)(lds + PG8_SA(b, h) + aoff + m * 2048 + k * 1024); } } while (0)
#define PG8_LDB(dst, b, h) do { if constexpr (FP8_) { _Pragma("unroll") for (int n = 0; n < 2; ++n) { const pg8_i32x4 lo_ = *(const PG8_LAS pg8_i32x4*)(lds + PG8_SB(b, h) + boff + n * 2048), hi_ = *(const PG8_LAS pg8_i32x4*)(lds + PG8_SB(b, h) + boff + n * 2048 + 1024); dst##8[n] = __builtin_shufflevector(lo_, hi_, 0, 1, 2, 3, 4, 5, 6, 7); } } \
        else { _Pragma("unroll") for (int n = 0; n < 2; ++n) _Pragma("unroll") for (int k = 0; k < 2; ++k) dst[n][k] = *(const PG8_LAS bf16x8*)(lds + PG8_SB(b, h) + boff + n * 2048 + k * 1024); } } while (0)
#define PG8_MMA(ai, bj, At, Bt) do { __builtin_amdgcn_s_setprio(1); \
        if constexpr (FP8_) { _Pragma("unroll") for (int m = 0; m < 4; ++m) { \
            f32x4 c0_ = __builtin_shufflevector(acc8[ai][bj][m], acc8[ai][bj][m], 0, 1, 2, 3), c1_ = __builtin_shufflevector(acc8[ai][bj][m], acc8[ai][bj][m], 4, 5, 6, 7); \
            asm volatile("v_mfma_scale_f32_16x16x128_f8f6f4 %0, %1, %2, %0, %3, %3 op_sel_hi:[0,0,0]" : "+v"(c0_) : "v"(Bt##8[0]), "v"(At##8[m]), "v"(sc127_));   \
            asm volatile("v_mfma_scale_f32_16x16x128_f8f6f4 %0, %1, %2, %0, %3, %3 op_sel_hi:[0,0,0]" : "+v"(c1_) : "v"(Bt##8[1]), "v"(At##8[m]), "v"(sc127_)); \
            acc8[ai][bj][m] = __builtin_shufflevector(c0_, c1_, 0, 1, 2, 3, 4, 5, 6, 7); } } \
        else { _Pragma("unroll") for (int m = 0; m < 4; ++m) _Pragma("unroll") for (int n = 0; n < 2; ++n) _Pragma("unroll") for (int k = 0; k < 2; ++k) \
            acc[ai][bj][m][n] = __builtin_amdgcn_mfma_f32_16x16x32_bf16(Bt[n][k], At[m][k], acc[ai][bj][m][n], 0, 0, 0); } \
        __builtin_amdgcn_s_setprio(0); } while (0)
#define PG8_WAIT_V(n) asm volatile("s_waitcnt vmcnt(" #n ")" ::: "memory")
#define PG8_WAIT_L(n) asm volatile("s_waitcnt lgkmcnt(" #n ")" ::: "memory")
#define PG8_BAR __builtin_amdgcn_s_barrier()
#define PG8_SCHED __builtin_amdgcn_sched_barrier(0)
#define PG8_KLOOP(F8, T0, T1) do { \
        for (int t = (T0); t < (T1); t += 2) { constexpr bool FP8_ = (F8); \
            const bool last = (t == nt - 2); \
            const char* a1 = cA + (size_t)(t + 1) * kstep; \
            const char* a2 = last ? nA : cA + (size_t)(t + 2) * kstep; const char* b2 = last ? nB : cB + (size_t)(t + 2) * kstep; \
            const char* a3 = a2 + kstep; const char* b3 = b2 + kstep; \
            if (last && has_next) S.a_ready(nxt); \
            PG8_LDB(B0, 0, 0); PG8_LDB(B1, 0, 1); PG8_SCHED; PG8_LDA(At, 0, 0); PG8_STAGE(PG8_SA(1, 1), a1 + hstep, voffA); \
            PG8_WAIT_V(8); PG8_WAIT_L(0); PG8_BAR; PG8_MMA(0, 0, At, B0); PG8_MMA(0, 1, At, B1); PG8_BAR; PG8_SCHED; \
            PG8_LDA(At, 0, 1); PG8_STAGE(PG8_SB(0, 0), b2, voffB); PG8_STAGE(PG8_SB(0, 1), b2 + hstep, voffB); PG8_STAGE(PG8_SA(0, 0), a2, voffA); \
            PG8_WAIT_V(8); PG8_WAIT_L(0); PG8_BAR; PG8_MMA(1, 0, At, B0); PG8_MMA(1, 1, At, B1); PG8_BAR; PG8_SCHED; \
            PG8_LDB(B0, 1, 0); PG8_LDB(B1, 1, 1); PG8_SCHED; PG8_LDA(At, 1, 0); PG8_STAGE(PG8_SA(0, 1), a2 + hstep, voffA); \
            PG8_WAIT_V(8); PG8_WAIT_L(0); PG8_BAR; PG8_MMA(0, 0, At, B0); PG8_MMA(0, 1, At, B1); PG8_BAR; PG8_SCHED; \
            PG8_LDA(At, 1, 1); PG8_STAGE(PG8_SB(1, 0), b3, voffB); PG8_STAGE(PG8_SB(1, 1), b3 + hstep, voffB); PG8_STAGE(PG8_SA(1, 0), a3, voffA); \
            PG8_WAIT_V(8); PG8_WAIT_L(0); PG8_BAR; PG8_MMA(1, 0, At, B0); PG8_MMA(1, 1, At, B1); PG8_BAR; PG8_SCHED; \
        } \
    } while (0)
    Unit cur, nxt; int ui = 0;
    if (!S.next(0, cur)) return;
    f32x4 acc[2][2][4][2];
    typedef float pg8_f32x8 __attribute__((ext_vector_type(8)));
    const int sc127_ = 127;
    pg8_f32x8 acc8[2][2][4];
#pragma unroll
    for (int a = 0; a < 2; ++a)
#pragma unroll
        for (int b = 0; b < 2; ++b)
#pragma unroll
            for (int m = 0; m < 4; ++m) acc8[a][b][m] = (pg8_f32x8){0.f, 0.f, 0.f, 0.f, 0.f, 0.f, 0.f, 0.f};
#pragma unroll
    for (int a = 0; a < 2; ++a)
#pragma unroll
        for (int b = 0; b < 2; ++b)
#pragma unroll
            for (int m = 0; m < 4; ++m)
#pragma unroll
                for (int n = 0; n < 2; ++n) acc[a][b][m][n] = (f32x4){0.f, 0.f, 0.f, 0.f};
    bf16x8 At[4][2], B0[2][2], B1[2][2]; pg8_i32x8 At8[4], B08[2], B18[2];
    const char* cA = (const char*)g.A + (size_t)cur.pm * tstep; const char* cB = (const char*)g.Bt + (size_t)cur.pn * tstep;
    S.a_ready(cur);
    if constexpr (SP2) {
        PG8_STAGE(PG8_SB(0, 0), cB, voffB); PG8_STAGE(PG8_SB(0, 1), cB + hstep, voffB); PG8_STAGE(PG8_SA(0, 0), cA, voffA); PG8_STAGE(PG8_SA(0, 1), cA + hstep, voffA);
        if (wr == 1) PG8_BAR;
        PG8_WAIT_V(2); PG8_BAR;
        PG8_STAGE(PG8_SB(1, 0), cB + kstep, voffB); PG8_STAGE(PG8_SA(1, 0), cA + kstep, voffA); PG8_STAGE(PG8_SB(1, 1), cB + hstep + kstep, voffB);
        PG8_WAIT_V(6); PG8_BAR;
    } else {
        PG8_STAGE(PG8_SB(0, 0), cB, voffB); PG8_STAGE(PG8_SA(0, 0), cA, voffA); PG8_STAGE(PG8_SB(0, 1), cB + hstep, voffB); PG8_STAGE(PG8_SA(0, 1), cA + hstep, voffA);
        if (wr == 1) PG8_BAR;
        PG8_WAIT_V(4); PG8_BAR;
        PG8_STAGE(PG8_SB(1, 0), cB + kstep, voffB); PG8_STAGE(PG8_SA(1, 0), cA + kstep, voffA); PG8_STAGE(PG8_SB(1, 1), cB + hstep + kstep, voffB);
        PG8_WAIT_V(6); PG8_BAR;
    }
    for (;;) {
        const bool has_next = S.next(ui + 1, nxt);
        const char* nA = has_next ? (const char*)g.A + (size_t)nxt.pm * tstep : cA; const char* nB = has_next ? (const char*)g.Bt + (size_t)nxt.pn * tstep : cB;
        static_assert(SP2, "the K-loop is the two-super-phase form");
        if constexpr (FP8 == 2) {
            PG8_KLOOP(true, 0, g.nt8);
#pragma unroll
            for (int a = 0; a < 2; ++a)
#pragma unroll
                for (int b = 0; b < 2; ++b)
#pragma unroll
                    for (int m = 0; m < 4; ++m) { acc[a][b][m][0] = __builtin_shufflevector(acc8[a][b][m], acc8[a][b][m], 0, 1, 2, 3) * (1.0f / 1024.0f); acc[a][b][m][1] = __builtin_shufflevector(acc8[a][b][m], acc8[a][b][m], 4, 5, 6, 7) * (1.0f / 1024.0f); }
            PG8_KLOOP(false, g.nt8, nt);
        } else if constexpr (FP8 == 1) { PG8_KLOOP(true, 0, nt); }
        else { PG8_KLOOP(false, 0, nt); }
        if constexpr (ALIGN_EPI) { if (wr == 0) PG8_BAR; }
        if constexpr (FP8 == 1) {
#pragma unroll
            for (int a = 0; a < 2; ++a)
#pragma unroll
                for (int b = 0; b < 2; ++b)
#pragma unroll
                    for (int m = 0; m < 4; ++m) { acc[a][b][m][0] = __builtin_shufflevector(acc8[a][b][m], acc8[a][b][m], 0, 1, 2, 3); acc[a][b][m][1] = __builtin_shufflevector(acc8[a][b][m], acc8[a][b][m], 4, 5, 6, 7); } }
        if constexpr (!Epi::AFTER_DRAIN) { E(acc, cur, wr, wc, fr, fq); S.done(cur); }
        if (!has_next) break;
#pragma unroll
        for (int a = 0; a < 2; ++a)
#pragma unroll
            for (int b = 0; b < 2; ++b)
#pragma unroll
                for (int m = 0; m < 4; ++m)
#pragma unroll
                    for (int n = 0; n < 2; ++n) acc[a][b][m][n] = (f32x4){0.f, 0.f, 0.f, 0.f};
        if constexpr (FP8 != 0) {
#pragma unroll
            for (int a = 0; a < 2; ++a)
#pragma unroll
                for (int b = 0; b < 2; ++b)
#pragma unroll
                    for (int m = 0; m < 4; ++m) acc8[a][b][m] = (pg8_f32x8){0.f, 0.f, 0.f, 0.f, 0.f, 0.f, 0.f, 0.f}; }
        cur = nxt; cA = nA; cB = nB; ++ui;
        if constexpr (ALIGN_EPI) { if (wr == 1) PG8_BAR; }
    }
    PG8_WAIT_V(0);
    if constexpr (!ALIGN_EPI) { if (wr == 0) PG8_BAR; }
    PG8_BAR;
    if constexpr (Epi::AFTER_DRAIN) { E.fused(acc, cur, wr, wc, fr, fq, lds, wid, lane); S.done(cur); }
#undef PG8_SA
#undef PG8_SB
#undef PG8_STAGE
#undef PG8_LDA
#undef PG8_LDB
#undef PG8_MMA
#undef PG8_WAIT_V
#undef PG8_WAIT_L
#undef PG8_BAR
#undef PG8_SCHED
#undef PG8_KLOOP
}
}
namespace att {
#define ALAS __attribute__((address_space(3)))
typedef unsigned short bf16;
typedef short bf16x8 __attribute__((ext_vector_type(8)));
typedef short s16x4 __attribute__((ext_vector_type(4)));
typedef float f32x16 __attribute__((ext_vector_type(16)));
typedef float f32x4 __attribute__((ext_vector_type(4)));
typedef unsigned u32x4 __attribute__((ext_vector_type(4)));
constexpr int PITCH = 12288;
constexpr int DM = 4096;
constexpr int OFF_K = 0, OFF_V = 32768, OFF_P = 98304;
constexpr int GK = 0, GV = 65536, OFF_TAB = 131072;
constexpr int OFF_WS = 138752, OFF_SSX = OFF_WS + 2048, ATT_LDS = OFF_SSX + 1024;
constexpr float LOG2E = 1.4426950408889634f;

#define KSWZ(row, colB) ((row) * 256 + ((colB) ^ (((row) & 7) << 4)))
#define ASBAR() __builtin_amdgcn_sched_barrier(0)
__device__ __forceinline__ constexpr int crow0(int r) { return (r & 3) + 8 * (r >> 2); }
__device__ __forceinline__ int crow(int r, int hi) { return (r & 3) + 8 * (r >> 2) + 4 * hi; }
__device__ __forceinline__ unsigned cvtpk(float lo, float hi) { unsigned r; asm volatile("v_cvt_pk_bf16_f32 %0, %1, %2" : "=v"(r) : "v"(lo), "v"(hi)); return r; }
__device__ __forceinline__ float bf2f(unsigned short b) { return __uint_as_float(((unsigned)b) << 16); }
__device__ __forceinline__ unsigned short f2bf(float f) { return (unsigned short)(cvtpk(f, f) & 0xffffu); }
__device__ __forceinline__ int v_st(int k, int c) { const int kk = (k & ~0xC) | ((k & 4) << 1) | ((k & 8) >> 1); return ((kk >> 3) * 4 + (c >> 5)) * 512 + ((kk & 7) * 32 + (c & 31)) * 2; }
__device__ __forceinline__ int v_rd_base(int lane) { return ((lane & 3) << 3) | (((lane >> 2) & 3) << 6) | (((lane >> 4) & 1) << 5) | (((lane >> 5) & 1) << 8); }
constexpr int v_rd_off(int d0, int ks, int half) { return d0 * 512 + ks * 4096 + half * 2048; }
template <int OFF> __device__ __forceinline__ s16x4 tr_read(int vb) { s16x4 r; asm volatile("ds_read_b64_tr_b16 %0, %1 offset:%2" : "=&v"(r) : "v"(vb), "i"(OFF) : "memory"); return r; }
struct VFragK { s16x4 l[4], h[4]; };
template <int KS> __device__ __forceinline__ void v_readk(VFragK& f, int vb) {
  f.l[0] = tr_read<v_rd_off(0, KS, 0)>(vb); f.h[0] = tr_read<v_rd_off(0, KS, 1)>(vb); f.l[1] = tr_read<v_rd_off(1, KS, 0)>(vb); f.h[1] = tr_read<v_rd_off(1, KS, 1)>(vb);
  f.l[2] = tr_read<v_rd_off(2, KS, 0)>(vb); f.h[2] = tr_read<v_rd_off(2, KS, 1)>(vb); f.l[3] = tr_read<v_rd_off(3, KS, 0)>(vb); f.h[3] = tr_read<v_rd_off(3, KS, 1)>(vb);
}
#define APK(L, H) (bf16x8){L[0], L[1], L[2], L[3], H[0], H[1], H[2], H[3]}
__device__ __forceinline__ void pv_d0(f32x16 (&o)[4], int vb, bf16x8 pa0, bf16x8 pa1, bf16x8 pa2, bf16x8 pa3) {
  VFragK A, B;
  v_readk<0>(A, vb);
  v_readk<1>(B, vb); asm volatile("s_waitcnt lgkmcnt(8)" ::: "memory"); ASBAR();
#pragma unroll
  for (int d = 0; d < 4; ++d) o[d] = __builtin_amdgcn_mfma_f32_32x32x16_bf16(pa0, APK(A.l[d], A.h[d]), o[d], 0, 0, 0);
  ASBAR(); v_readk<2>(A, vb); asm volatile("s_waitcnt lgkmcnt(8)" ::: "memory"); ASBAR();
#pragma unroll
  for (int d = 0; d < 4; ++d) o[d] = __builtin_amdgcn_mfma_f32_32x32x16_bf16(pa1, APK(B.l[d], B.h[d]), o[d], 0, 0, 0);
  ASBAR(); v_readk<3>(B, vb); asm volatile("s_waitcnt lgkmcnt(8)" ::: "memory"); ASBAR();
#pragma unroll
  for (int d = 0; d < 4; ++d) o[d] = __builtin_amdgcn_mfma_f32_32x32x16_bf16(pa2, APK(A.l[d], A.h[d]), o[d], 0, 0, 0);
  ASBAR(); asm volatile("s_waitcnt lgkmcnt(0)" ::: "memory"); ASBAR();
#pragma unroll
  for (int d = 0; d < 4; ++d) o[d] = __builtin_amdgcn_mfma_f32_32x32x16_bf16(pa3, APK(B.l[d], B.h[d]), o[d], 0, 0, 0);
  ASBAR();
}
__device__ __forceinline__ void qkt(f32x16& p0, f32x16& p1, const ALAS char* Ks, const bf16x8 (&qr)[8], int r32, int hi) {
  for (int r = 0; r < 16; ++r) { p0[r] = 0.f; p1[r] = 0.f; }
  bf16x8 k0[8], k1[8];
#pragma unroll
  for (int d0 = 0; d0 < 8; ++d0) { k0[d0] = *(const ALAS bf16x8*)(Ks + KSWZ(r32, (d0 * 16 + hi * 8) * 2)); k1[d0] = *(const ALAS bf16x8*)(Ks + KSWZ(32 + r32, (d0 * 16 + hi * 8) * 2)); }
  asm volatile("s_waitcnt lgkmcnt(8)" ::: "memory"); ASBAR();
#pragma unroll
  for (int d0 = 0; d0 < 4; ++d0) { p0 = __builtin_amdgcn_mfma_f32_32x32x16_bf16(k0[d0], qr[d0], p0, 0, 0, 0); p1 = __builtin_amdgcn_mfma_f32_32x32x16_bf16(k1[d0], qr[d0], p1, 0, 0, 0); }
  asm volatile("s_waitcnt lgkmcnt(0)" ::: "memory"); ASBAR();
#pragma unroll
  for (int d0 = 4; d0 < 8; ++d0) { p0 = __builtin_amdgcn_mfma_f32_32x32x16_bf16(k0[d0], qr[d0], p0, 0, 0, 0); p1 = __builtin_amdgcn_mfma_f32_32x32x16_bf16(k1[d0], qr[d0], p1, 0, 0, 0); }
}
struct TileParams {
  const bf16* qrow;
  const bf16* kp;
  const bf16* vp;
  size_t kstride;
  int nt;
  int jact_lo, jact_hi;
  float fa;
  float slope;
  int tb;
  int ucs;
  float sh;
};
template <int MODE>
__device__ __forceinline__ void attn_tiles(ALAS char* lds, const TileParams& tp, f32x16 (&o)[4], float& l_reg, int tid) {
  const int wid = __builtin_amdgcn_readfirstlane(tid >> 6), lane = tid & 63, r32 = lane & 31, hi = lane >> 5;
  const ALAS float* tab = (const ALAS float*)(lds + OFF_TAB);
  bf16x8 qr[8];
#pragma unroll
  for (int d0 = 0; d0 < 8; ++d0) qr[d0] = *(const bf16x8*)(tp.qrow + d0 * 16);
  const int vb0 = (int)(unsigned)(uintptr_t)(lds + GV) + v_rd_base(lane);
  unsigned koff[2], voff[2];
#pragma unroll
  for (int i = 0; i < 2; ++i) { const int q = 2 * wid + i;
    const int krow = 4 * q + (lane >> 4), kcolB = ((lane & 15) << 4) ^ ((krow & 7) << 4);
    koff[i] = (unsigned)krow * (unsigned)(tp.kstride * 2) + (unsigned)kcolB;
    const int sub = 2 * q + (lane >> 5), kk = (sub >> 2) * 8 + ((lane & 31) >> 2), c = (sub & 3) * 32 + (lane & 3) * 8, k = (kk & ~0xC) | ((kk & 4) << 1) | ((kk & 8) >> 1);
    voff[i] = (unsigned)k * (unsigned)(tp.kstride * 2) + (unsigned)(c * 2); }
#define DMA(j) do { const int sl_ = (((j) >> 1) & 1) * 2 + ((j) & 1); const char* kb_ = (const char*)tp.kp + (size_t)(j) * 128 * tp.kstride; const char* vb_ = (const char*)tp.vp + (size_t)(j) * 128 * tp.kstride; \
    _Pragma("unroll") for (int i_ = 0; i_ < 2; ++i_) __builtin_amdgcn_global_load_lds((const unsigned*)(kb_ + koff[i_]), (ALAS unsigned*)(lds + GK + sl_ * 16384 + (2 * wid + i_) * 1024), 16, 0, 0); \
    _Pragma("unroll") for (int i_ = 0; i_ < 2; ++i_) __builtin_amdgcn_global_load_lds((const unsigned*)(vb_ + voff[i_]), (ALAS unsigned*)(lds + GV + sl_ * 16384 + (2 * wid + i_) * 1024), 16, 0, 0); } while (0)
  DMA(0); if (tp.nt > 1) DMA(1);
  for (int j0 = 0; j0 < tp.nt; j0 += 2) {
    asm volatile("s_waitcnt vmcnt(0)" ::: "memory"); __syncthreads();
    if (j0 + 2 < tp.nt) DMA(j0 + 2);
    if (j0 + 3 < tp.nt) DMA(j0 + 3);
#pragma unroll 1
    for (int j = j0; j < j0 + 2; ++j) {
    const int b = ((j >> 1) & 1) * 2 + (j & 1);
    const bool act = (j < tp.nt) && (j >= tp.jact_lo && j <= tp.jact_hi);
    if (act) {
      f32x16 p0, p1;
      qkt(p0, p1, lds + GK + b * 16384, qr, r32, hi);
      if constexpr (MODE == 2) {
        const float a = tp.fa - (float)(64 * j);
#pragma unroll
        for (int r = 0; r < 16; ++r) { const float d0 = fabsf(a - (float)crow0(r)), d1 = fabsf(a - (float)(32 + crow0(r)));
          p0[r] = d0 <= 64.f ? fmaf(-tp.slope, d0, p0[r]) : -INFINITY; p1[r] = d1 <= 64.f ? fmaf(-tp.slope, d1, p1[r]) : -INFINITY; }
        if (tp.sh != 0.f) {
#pragma unroll
          for (int r = 0; r < 16; ++r) { p0[r] -= tp.sh; p1[r] -= tp.sh; } }
      } else {
        const int tbj = tp.tb + 128 * j;
#pragma unroll
        for (int r = 0; r < 16; ++r) { const float b0 = tab[tbj + crow0(r)], b1 = tab[tbj + 32 + crow0(r)];
          p0[r] = (unsigned)(tp.ucs + crow0(r)) < 16u ? p0[r] + b0 : -INFINITY; p1[r] = (unsigned)(tp.ucs + 32 + crow0(r)) < 16u ? p1[r] + b1 : -INFINITY; }
      }
#pragma unroll
      for (int r = 0; r < 16; ++r) { p0[r] = __builtin_amdgcn_exp2f(p0[r]); p1[r] = __builtin_amdgcn_exp2f(p1[r]); }
      float ps = 0.f;
#pragma unroll
      for (int r = 0; r < 16; ++r) ps += p0[r] + p1[r];
      { auto rr = __builtin_amdgcn_permlane32_swap(__float_as_uint(ps), __float_as_uint(ps), false, false); ps = __uint_as_float(rr[0]) + __uint_as_float(rr[1]); }
      l_reg += ps;
      bf16x8 pa0, pa1, pa2, pa3;
#define PK4(P, BASE, OUT) do { unsigned a0 = cvtpk(P[BASE + 0], P[BASE + 1]), a1 = cvtpk(P[BASE + 2], P[BASE + 3]);   \
    unsigned b0_ = cvtpk(P[BASE + 4], P[BASE + 5]), b1_ = cvtpk(P[BASE + 6], P[BASE + 7]);                              \
    auto r0 = __builtin_amdgcn_permlane32_swap(a0, b0_, false, false); auto r1 = __builtin_amdgcn_permlane32_swap(a1, b1_, false, false); \
    u32x4 w = {r0[0], r1[0], r0[1], r1[1]}; OUT = *reinterpret_cast<bf16x8*>(&w); } while (0)
      PK4(p0, 0, pa0); PK4(p0, 8, pa1); PK4(p1, 0, pa2); PK4(p1, 8, pa3);
      pv_d0(o, vb0 + b * 16384, pa0, pa1, pa2, pa3);
    }
    }
  }
#undef DMA
}
__device__ __forceinline__ void attn_tiles_A(ALAS char* lds, const TileParams& tp, f32x16 (&o)[4], float& l_reg, int tid) {
  const int wid = __builtin_amdgcn_readfirstlane(tid >> 6), lane = tid & 63, r32 = lane & 31, hi = lane >> 5, kh = wid >> 2;
  bf16x8 qr[8];
#pragma unroll
  for (int d0 = 0; d0 < 8; ++d0) qr[d0] = *(const bf16x8*)(tp.qrow + d0 * 16);
  const int vb0 = (int)(unsigned)(uintptr_t)(lds + OFF_V) + kh * 16384 + v_rd_base(lane);
  unsigned koff[2], voff[2];
#pragma unroll
  for (int i = 0; i < 2; ++i) { const int q = 2 * wid + i;
    const int krow = 4 * q + (lane >> 4), kcolB = ((lane & 15) << 4) ^ ((krow & 7) << 4);
    koff[i] = (unsigned)krow * (unsigned)(tp.kstride * 2) + (unsigned)kcolB;
    const int sub = 2 * q + (lane >> 5), kk = (sub >> 2) * 8 + ((lane & 31) >> 2), c = (sub & 3) * 32 + (lane & 3) * 8, k = (kk & ~0xC) | ((kk & 4) << 1) | ((kk & 8) >> 1);
    voff[i] = (unsigned)k * (unsigned)(tp.kstride * 2) + (unsigned)(c * 2); }
#define DMA_K(j, b) do { const char* kb_ = (const char*)tp.kp + (size_t)(j) * 128 * tp.kstride; \
    _Pragma("unroll") for (int i_ = 0; i_ < 2; ++i_) __builtin_amdgcn_global_load_lds((const unsigned*)(kb_ + koff[i_]), (ALAS unsigned*)(lds + OFF_K + (b) * 16384 + (2 * wid + i_) * 1024), 16, 0, 0); } while (0)
#define DMA_V(j, b) do { const char* vb_ = (const char*)tp.vp + (size_t)(j) * 128 * tp.kstride; \
    _Pragma("unroll") for (int h_ = 0; h_ < 2; ++h_) _Pragma("unroll") for (int i_ = 0; i_ < 2; ++i_) \
      __builtin_amdgcn_global_load_lds((const unsigned*)(vb_ + voff[i_] + h_ * 256), (ALAS unsigned*)(lds + OFF_V + ((b) * 2 + h_) * 16384 + (2 * wid + i_) * 1024), 16, 0, 0); } while (0)
  ALAS char* pmine = lds + OFF_P + (wid * 2) * 1024 + lane * 16;
  const ALAS char* ppart = lds + OFF_P + ((wid ^ 4) * 2) * 1024 + lane * 16;
  const ALAS char* krow_base = lds + OFF_K;
  bf16x8 m0 = {}, m1 = {};
  DMA_K(0, 0);
  for (int j = 0; j <= tp.nt; ++j) {
    asm volatile("s_waitcnt vmcnt(0)" ::: "memory"); __syncthreads();
    if (j + 1 < tp.nt) DMA_K(j + 1, (j + 1) & 1);
    if (j < tp.nt) DMA_V(j, j & 1);
    bf16x8 n0 = m0, n1 = m1;
#define S_STEP() do {                                                                                                          \
      f32x16 p, pB_; for (int r = 0; r < 16; ++r) { p[r] = 0.f; pB_[r] = 0.f; }                                               \
      bf16x8 kf[8]; const ALAS char* Ks = krow_base + (j & 1) * 16384;                                                         \
      _Pragma("unroll") for (int d0 = 0; d0 < 8; ++d0) kf[d0] = *(const ALAS bf16x8*)(Ks + KSWZ(32 * kh + r32, (d0 * 16 + hi * 8) * 2)); \
      asm volatile("s_waitcnt lgkmcnt(0)" ::: "memory"); ASBAR();                                                              \
      _Pragma("unroll") for (int d0 = 0; d0 < 8; d0 += 2) { p = __builtin_amdgcn_mfma_f32_32x32x16_bf16(kf[d0], qr[d0], p, 0, 0, 0); pB_ = __builtin_amdgcn_mfma_f32_32x32x16_bf16(kf[d0 + 1], qr[d0 + 1], pB_, 0, 0, 0); }   \
      _Pragma("unroll") for (int r = 0; r < 16; ++r) p[r] += pB_[r];                                                            \
      const float a = tp.fa - (float)(64 * j + 32 * kh);                                                                       \
      _Pragma("unroll") for (int r = 0; r < 16; ++r) p[r] = fmaf(-tp.slope, fabsf(a - (float)crow0(r)), p[r]);                 \
      if (tp.sh != 0.f) { _Pragma("unroll") for (int r = 0; r < 16; ++r) p[r] -= tp.sh; }                                      \
      _Pragma("unroll") for (int r = 0; r < 16; ++r) p[r] = __builtin_amdgcn_exp2f(p[r]);                                      \
      float ps = 0.f;                                                                                                          \
      _Pragma("unroll") for (int r = 0; r < 16; ++r) ps += p[r];                                                               \
      { auto rr = __builtin_amdgcn_permlane32_swap(__float_as_uint(ps), __float_as_uint(ps), false, false); ps = __uint_as_float(rr[0]) + __uint_as_float(rr[1]); } \
      l_reg += ps;                                                                                                             \
      PK4(p, 0, n0); PK4(p, 8, n1);                                                                                            \
      *(ALAS bf16x8*)(pmine + (j & 1) * 16384) = n0; *(ALAS bf16x8*)(pmine + (j & 1) * 16384 + 1024) = n1;                     \
    } while (0)
    if (kh == 1 && j < tp.nt) S_STEP();
    if (j > 0) {
      const int pb = (j - 1) & 1;
      const bf16x8 x0 = *(const ALAS bf16x8*)(ppart + pb * 16384), x1 = *(const ALAS bf16x8*)(ppart + pb * 16384 + 1024);
      const bool lo_half = (kh == 0);
      const bf16x8 pa0 = lo_half ? m0 : x0, pa1 = lo_half ? m1 : x1, pa2 = lo_half ? x0 : m0, pa3 = lo_half ? x1 : m1;
      pv_d0(o, vb0 + pb * 32768, pa0, pa1, pa2, pa3);
    }
    if (kh == 0 && j < tp.nt) S_STEP();
#undef S_STEP
    m0 = n0; m1 = n1;
  }
#undef PK4
#undef DMA_K
#undef DMA_V
  ALAS float* ssx = (ALAS float*)(lds + OFF_SSX);
  if (hi == 0) ssx[wid * 32 + r32] = l_reg;
  __syncthreads();
  l_reg += ssx[(wid ^ 4) * 32 + r32];
  __syncthreads();
}
__device__ __forceinline__ void row_bcast(ALAS char* lds, int wid, int r32, int hi, float v, float (&out)[16]) {
  ALAS float* li_l = (ALAS float*)(lds + OFF_WS) + wid * 64;
  if (hi == 0) li_l[r32] = v; asm volatile("s_waitcnt lgkmcnt(0)" ::: "memory");
#pragma unroll
  for (int r = 0; r < 16; ++r) out[r] = li_l[crow(r, hi)];
  asm volatile("s_waitcnt lgkmcnt(0)" ::: "memory");
}
__device__ __forceinline__ float swz_xor(float v, int) = delete;
template <int MASK> __device__ __forceinline__ float swz_xor(float v) { return __int_as_float(__builtin_amdgcn_ds_swizzle(__float_as_int(v), 0x1f | (MASK << 10))); }
__device__ __forceinline__ float half_sum(float v) {
  v += swz_xor<1>(v); v += swz_xor<2>(v); v += swz_xor<4>(v); v += swz_xor<8>(v); v += swz_xor<16>(v);
  return v;
}
__device__ __forceinline__ float wave_sum_sw(float v) {
  v = half_sum(v); auto rr = __builtin_amdgcn_permlane32_swap(__float_as_uint(v), __float_as_uint(v), false, false); return __uint_as_float(rr[0]) + __uint_as_float(rr[1]);
}
__device__ __forceinline__ float wave_max_sw(float v) {
  v = fmaxf(v, swz_xor<1>(v)); v = fmaxf(v, swz_xor<2>(v)); v = fmaxf(v, swz_xor<4>(v)); v = fmaxf(v, swz_xor<8>(v)); v = fmaxf(v, swz_xor<16>(v));
  auto rr = __builtin_amdgcn_permlane32_swap(__float_as_uint(v), __float_as_uint(v), false, false); return fmaxf(__uint_as_float(rr[0]), __uint_as_float(rr[1]));
}
}
constexpr int NWAVES = 8;
constexpr int BATCH = 2, SEQ = 4096, D = 4096, M = BATCH * SEQ, INW = 12288, FF = 11008, NLAYER = 2;
constexpr int NIN = 22;
#ifndef F8_DOWN
#define F8_DOWN 2
#endif
constexpr float RMS_EPS = 1e-6f;

constexpr float QSCALE = 0.08838834764831845f * att::LOG2E;
constexpr int C_QA = 0, C_KA = 1024, C_VA = 2048, C_QB = 3072, C_KB = 4608, C_VB = 6144, C_QC = 7680, C_KC = 9216, C_VC = 10752;
constexpr size_t MiB = 1u << 20;
constexpr size_t WS_CTL = 0, CTL_ZERO_BYTES = 1 * MiB;
constexpr size_t WSZ_WIN = (size_t)INW * D * 2, WSZ_WOUT = (size_t)D * D * 2, WSZ_WGU = (size_t)2 * FF * D * 2, WSZ_WDN = (size_t)D * FF * 2, WSZ_LAYER = WSZ_WIN + WSZ_WOUT + WSZ_WGU + WSZ_WDN;
constexpr size_t WS_W = 1 * MiB;
constexpr size_t WS_H = WS_W + NLAYER * WSZ_LAYER;
constexpr size_t WS_PROJ = WS_H + (size_t)M * D * 2;
constexpr size_t WS_MIX = WS_PROJ + (size_t)M * INW * 2;
constexpr size_t WS_CO = WS_MIX + (size_t)M * D * 2;
constexpr size_t WS_LSE = WS_CO + (size_t)3 * M * 1536 * 2;
constexpr size_t WS_PS = WS_LSE + 2 * MiB;
constexpr size_t WS_X0 = WS_PS + (size_t)3 * M * 64 * 4;
constexpr size_t WS_X1 = WS_X0 + (size_t)M * D * 2;
constexpr size_t WS_SCRA = WS_X1 + (size_t)M * D * 2;
constexpr size_t WS_END = WS_SCRA + (size_t)256 * 128 * 256 * 4;
constexpr int CW_TMO = 0, CW_Q = 2048  , CW_BAR = 4096, CW_SS = 131072;
constexpr int RING_OFF = 0, RING_BYTES = 143360;
constexpr int LDSCTL_OFF = RING_BYTES, MISC_OFF = LDSCTL_OFF + 320;
constexpr int LDS_BYTES = 147456;
static_assert(att::ATT_LDS <= RING_BYTES, "attention LDS");
#define GAS __attribute__((address_space(1)))
#define LAS __attribute__((address_space(3)))
typedef unsigned short bf16;
typedef unsigned v4u __attribute__((ext_vector_type(4)));
typedef unsigned v2u __attribute__((ext_vector_type(2)));
typedef float f32x4 __attribute__((ext_vector_type(4)));
typedef short bf16x8 __attribute__((ext_vector_type(8)));
typedef GAS unsigned gu32;
#define RLX_AGENT __ATOMIC_RELAXED, __HIP_MEMORY_SCOPE_AGENT
#define LDS_WAIT() asm volatile("s_waitcnt lgkmcnt(0)" ::: "memory")
__device__ __forceinline__ unsigned f2bf(float f) { unsigned u = __builtin_bit_cast(unsigned, f); return (u + 0x7fffu + ((u >> 16) & 1u)) >> 16; }
__device__ __forceinline__ unsigned pk2(float lo, float hi) { return pg8::cvt_pk_bf16(lo, hi); }
__device__ __forceinline__ float bflo(unsigned w) { return __uint_as_float(w << 16); }
__device__ __forceinline__ float bfhi(unsigned w) { return __uint_as_float(w & 0xffff0000u); }
#define XB_TMO      128
#define XB_XCNT(j)  (256  + 64 * (j))
#define XB_XSUB(j)  (1280 + 64 * (j))
#define XB_XGEN(j)  (2304 + 64 * (j))
#define XB_TOP      3328
#define XB_TOPGEN   3392
#define XCD_BAR_WORDS 3456
#define XB_SPIN_CAP (1u << 18)

__device__ __forceinline__ unsigned xb_ld(unsigned* p)              { return __hip_atomic_load(p, __ATOMIC_RELAXED, __HIP_MEMORY_SCOPE_AGENT); }
__device__ __forceinline__ unsigned xb_add(unsigned* p, unsigned v) { return __hip_atomic_fetch_add(p, v, __ATOMIC_RELAXED, __HIP_MEMORY_SCOPE_AGENT); }
__device__ __forceinline__ unsigned xb_xcc_id() { return (unsigned)__builtin_amdgcn_s_getreg((3 << 11) | 20) & 0xFu; }
#define XB_SPIN(cond, bar) do { unsigned _sp = 0; while (cond) { __builtin_amdgcn_s_sleep(1); \
    if ((++_sp & 255u) == 0u) { if (xb_ld(&(bar)[XB_TMO])) break; if (_sp > XB_SPIN_CAP) { atomicAdd(&(bar)[XB_TMO], 1u); break; } } } } while (0)

struct XcdBarrier {
    unsigned* bar; unsigned x;
    volatile LAS unsigned* st;
};

__device__ __forceinline__ XcdBarrier xcd_barrier_post(unsigned* bar, volatile LAS unsigned* st) {
    XcdBarrier b; b.bar = bar; b.x = xb_xcc_id(); b.st = st;
    if (threadIdx.x == 0) (void)xb_add(&bar[XB_XCNT(b.x)], 1u);
    return b;
}
__device__ __forceinline__ void xcd_barrier_complete(unsigned* bar, unsigned x, unsigned& nloc, unsigned& nx) {
    const unsigned G = gridDim.x * gridDim.y * gridDim.z;
    unsigned sum, cnt, mine, sp = 0u;
    for (;;) {
        sum = 0u; cnt = 0u; mine = 0u;
#pragma unroll
        for (unsigned j = 0; j < 16; ++j) { const unsigned c = xb_ld(&bar[XB_XCNT(j)]); sum += c; cnt += (c > 0u) ? 1u : 0u; mine = (j == x) ? c : mine; }
        if (sum == G) break;
        __builtin_amdgcn_s_sleep(1);
        if ((++sp & 255u) == 0u) { if (xb_ld(&bar[XB_TMO])) break; if (sp > XB_SPIN_CAP) { atomicAdd(&bar[XB_TMO], 1u); break; } }
    }
    nloc = mine > 0u ? mine : 1u; nx = cnt > 0u ? cnt : 1u;
}

__device__ __forceinline__ void xcd_barrier(const XcdBarrier& b) {
    asm volatile("s_waitcnt vmcnt(0)" ::: "memory");
    __syncthreads();
    if (threadIdx.x == 0) {
        unsigned* bar = b.bar;
        __builtin_amdgcn_s_waitcnt(0);
        unsigned nloc = b.st[0], nx = b.st[1];
        if (nloc == 0u) { xcd_barrier_complete(bar, b.x, nloc, nx); b.st[0] = nloc; b.st[1] = nx; }
        const unsigned old = xb_add(&bar[XB_XSUB(b.x)], 1u);
        const unsigned gen = old / nloc;
        if (old + 1u == (gen + 1u) * nloc) {
            __builtin_amdgcn_fence(__ATOMIC_RELEASE, "agent");
            asm volatile("s_waitcnt vmcnt(0)" ::: "memory");
            const unsigned og = xb_add(&bar[XB_TOP], 1u);
            const unsigned tg = og / nx;
            if (og + 1u == (tg + 1u) * nx) xb_add(&bar[XB_TOPGEN], 1u);
            else XB_SPIN(xb_ld(&bar[XB_TOPGEN]) == tg, bar);
            __builtin_amdgcn_fence(__ATOMIC_ACQUIRE, "agent");
            xb_add(&bar[XB_XGEN(b.x)], 1u);
            asm volatile("s_waitcnt vmcnt(0)" ::: "memory");
        } else {
            XB_SPIN(xb_ld(&bar[XB_XGEN(b.x)]) == gen, bar);
            __builtin_amdgcn_fence(__ATOMIC_ACQUIRE, "agent");
            asm volatile("s_waitcnt vmcnt(0)" ::: "memory");
        }
    }
    __syncthreads();
}
__device__ __forceinline__ float wave_sum(float v) { return att::wave_sum_sw(v); }
template <bool F8 = false>
__device__ __forceinline__ void p0_transpose_item(const float* W, int K, int N, bf16* WT, int k0, int n0, int drow0, LAS float* scr, int lane, const float* gk) {
    const int c = lane & 7;
    f32x4 g0 = {1.f, 1.f, 1.f, 1.f}, g1 = g0;
    if (gk) { g0 = *(const GAS f32x4*)(gk + k0 + 8 * c); g1 = *(const GAS f32x4*)(gk + k0 + 8 * c + 4); }
    const float* wp = W + (size_t)k0 * N + n0 + lane;
    float v[64];
#pragma unroll
    for (int i = 0; i < 64; ++i) v[i] = wp[(size_t)i * N];
#pragma unroll
    for (int i = 0; i < 64; ++i) scr[i * 65 + lane] = v[i];
    LDS_WAIT(); asm volatile("" ::: "memory");
#pragma unroll
    for (int j = 0; j < 8; ++j) { const int n = (lane >> 3) + 8 * j; const LAS float* s = scr + (8 * c) * 65 + n;
        if constexpr (F8) {
            unsigned w0 = 0u, w1 = 0u;
#define W8V(x) __builtin_amdgcn_fmed3f(64.f * (x), -448.f, 448.f)
            w0 = __builtin_amdgcn_cvt_pk_fp8_f32(W8V(s[0 * 65]), W8V(s[1 * 65]), w0, false); w0 = __builtin_amdgcn_cvt_pk_fp8_f32(W8V(s[2 * 65]), W8V(s[3 * 65]), w0, true);
            w1 = __builtin_amdgcn_cvt_pk_fp8_f32(W8V(s[4 * 65]), W8V(s[5 * 65]), w1, false); w1 = __builtin_amdgcn_cvt_pk_fp8_f32(W8V(s[6 * 65]), W8V(s[7 * 65]), w1, true);
#undef W8V
            *(GAS v2u*)((unsigned char*)WT + (size_t)(drow0 + n) * K + k0 + 8 * c) = (v2u){w0, w1};
        } else {
        v4u o; o.x = pk2(s[0 * 65] * g0.x, s[1 * 65] * g0.y); o.y = pk2(s[2 * 65] * g0.z, s[3 * 65] * g0.w); o.z = pk2(s[4 * 65] * g1.x, s[5 * 65] * g1.y); o.w = pk2(s[6 * 65] * g1.z, s[7 * 65] * g1.w);
        *(GAS v4u*)(WT + (size_t)(drow0 + n) * K + k0 + 8 * c) = o; } }
    LDS_WAIT(); asm volatile("" ::: "memory");
}
constexpr int RSTAB_OFF = 139264;
__device__ __forceinline__ void build_rstab(LAS unsigned char* lds, const float* ps, int np, int pm, int tid) {
    LAS float* tab = (LAS float*)(lds + RSTAB_OFF);
    const int r = tid >> 1, half = tid & 1, h = np > 1 ? np / 2 : 1; const float* p = ps + (size_t)(pm * 256 + r) * np + half * h;
    float s = 0.f;
    if (np == 64) { const GAS f32x4* p4 = (const GAS f32x4*)p; f32x4 v[8];
#pragma unroll
        for (int i = 0; i < 8; ++i) v[i] = p4[i];
#pragma unroll
        for (int i = 0; i < 8; ++i) s += (v[i].x + v[i].y) + (v[i].z + v[i].w); }
    else if (np > 1 || half == 0) for (int i = 0; i < h; ++i) s += p[i];
    const float o = att::swz_xor<1>(s);
    const float tot = half ? o + s : s + o;
    if (half == 0) tab[r] = __builtin_amdgcn_rsqf(tot * (1.0f / 4096.0f) + 1e-6f);
    __syncthreads();
}
struct Args { const float* in[NIN]; float* out; unsigned char* ws; int ph_lo, ph_hi; };
static_assert(sizeof(Args) == NIN * 8 + 8 + 8 + 8, "Args has no padding");
constexpr int NPH_LAYER = 6, NPHASE = 1 + NLAYER * NPH_LAYER;
#define CAS __attribute__((address_space(4)))
#define INP(k) ((const float*)(const GAS float*)ap->in[k])
#ifndef MIX_DOWN
#define MIX_DOWN 0
#endif
#ifndef MIX_T8
#define MIX_T8 40
#endif
constexpr int MIXK8 = MIX_T8 * 128, MIX_PITCH = MIXK8 + 2 * (FF - MIXK8);
static_assert(MIX_T8 % 2 == 0 && MIXK8 % 128 == 0 && ((FF - MIXK8) / 64) % 2 == 0 && (FF - MIXK8) % 64 == 0 && MIXK8 % 64 == 0 && (MIX_PITCH & (MIX_PITCH - 1)) != 0 && (MIX_DOWN & F8_DOWN) == 0, "mixed-K split");
#ifndef MIX_GU
#define MIX_GU 2
#endif
#ifndef GU_T8
#define GU_T8 20
#endif
constexpr int GUK8 = GU_T8 * 128, GU_PITCH = GUK8 + 2 * (D - GUK8);
static_assert(GU_T8 % 2 == 0 && GUK8 % 256 == 0 && GUK8 < D && ((D - GUK8) / 64) % 2 == 0 && (GU_PITCH & (GU_PITCH - 1)) != 0 && (size_t)GU_PITCH <= (size_t)D * 2, "mixed-K gate|up split");
constexpr int I_IN = (D / 64) * (INW / 64), I_OUT = (D / 64) * (D / 64), I_G = (D / 64) * (FF / 64), I_DN = (FF / 64) * (D / 64);
constexpr int I_LAYER = I_IN + I_OUT + 2 * I_G + I_DN;
struct CvDesc { const float* src; unsigned char* dst; const float* gk; int N, pitch, f8; float gsel; };
__device__ __forceinline__ CvDesc cv_decode(int it, const CAS Args* ap, unsigned char* ws) {
    CvDesc d; const int l = it / I_LAYER; int r = it - l * I_LAYER;
    unsigned char* wl = ws + WS_W + (size_t)l * WSZ_LAYER;
    d.f8 = 0; d.gsel = 0.f; d.gk = INP(1);
    if (r < I_IN) { const int nblk = INW / 64, kb = r / nblk, nb = r % nblk; d.src = INP(2) + (size_t)l * D * INW + (size_t)(64 * kb) * INW + 64 * nb; d.N = INW; d.pitch = D * 2;
        d.dst = wl + ((size_t)(64 * nb) * D + 64 * kb) * 2; d.gk = INP(1) + (size_t)l * D + 64 * kb; d.gsel = 1.f; return d; } r -= I_IN;
    if (r < I_OUT) { const int nblk = D / 64, kb = r / nblk, nb = r % nblk; d.src = INP(17) + (size_t)l * D * D + (size_t)(64 * kb) * D + 64 * nb; d.N = D; d.pitch = D * 2;
        d.dst = wl + WSZ_WIN + ((size_t)(64 * nb) * D + 64 * kb) * 2; return d; } r -= I_OUT;
    if (r < 2 * I_G) { const int up = r >= I_G; if (up) r -= I_G; const int nblk = FF / 64, kb = r / nblk, nb = r % nblk, n0 = 64 * nb;
        d.src = INP(up ? 20 : 19) + (size_t)l * D * FF + (size_t)(64 * kb) * FF + n0; d.N = FF; d.pitch = D * 2;
        const size_t drow = (size_t)((n0 >> 7) * 256 + up * 128 + (n0 & 127)); d.gk = INP(18) + (size_t)l * D + 64 * kb; d.gsel = 1.f;
        if ((MIX_GU >> l) & 1) { d.pitch = GU_PITCH; const int k0 = 64 * kb;
            if (k0 < GUK8) { d.f8 = 1; d.dst = wl + WSZ_WIN + WSZ_WOUT + drow * GU_PITCH + k0; } else d.dst = wl + WSZ_WIN + WSZ_WOUT + drow * GU_PITCH + GUK8 + (size_t)(k0 - GUK8) * 2; }
        else d.dst = wl + WSZ_WIN + WSZ_WOUT + (drow * D + 64 * kb) * 2;
        return d; } r -= 2 * I_G;
    { const int nblk = D / 64, kb = r / nblk, nb = r % nblk; d.src = INP(21) + (size_t)l * FF * D + (size_t)(64 * kb) * D + 64 * nb; d.N = D;
      unsigned char* wd = wl + WSZ_WIN + WSZ_WOUT + WSZ_WGU;
      if ((F8_DOWN >> l) & 1) { d.f8 = 1; d.pitch = FF; d.dst = wd + (size_t)(64 * nb) * FF + 64 * kb; }
      else if ((MIX_DOWN >> l) & 1) { d.pitch = MIX_PITCH; const int k0 = 64 * kb;
          if (k0 < MIXK8) { d.f8 = 1; d.dst = wd + (size_t)(64 * nb) * MIX_PITCH + k0; } else d.dst = wd + (size_t)(64 * nb) * MIX_PITCH + MIXK8 + (size_t)(k0 - MIXK8) * 2; }
      else { d.pitch = FF * 2; d.dst = wd + ((size_t)(64 * nb) * FF + 64 * kb) * 2; } }
    return d;
}
#ifndef CV_NT
#define CV_NT 3
#endif
struct CvRegs { f32x4 v[16]; f32x4 g0, g1; };
__device__ __forceinline__ void cv_load(const CvDesc& d, int lane, CvRegs& R) {
    const float* wp = d.src + (size_t)(lane >> 4) * d.N + 4 * (lane & 15);
    R.g0 = *(const GAS f32x4*)(d.gk + 8 * (lane & 7)); R.g1 = *(const GAS f32x4*)(d.gk + 8 * (lane & 7) + 4);
#pragma unroll
#if (CV_NT & 1)
    for (int i = 0; i < 16; ++i) R.v[i] = __builtin_nontemporal_load((const GAS f32x4*)(wp + (size_t)(4 * i) * d.N));
#else
    for (int i = 0; i < 16; ++i) R.v[i] = *(const GAS f32x4*)(wp + (size_t)(4 * i) * d.N);
#endif
}
__device__ __forceinline__ void cv_finish(const CvDesc& d, int lane, const CvRegs& R, LAS float* scr) {
    { LAS float* w = scr + (lane >> 4) * 65 + 4 * (lane & 15);
#pragma unroll
      for (int i = 0; i < 16; ++i) { w[(4 * i) * 65 + 0] = R.v[i].x; w[(4 * i) * 65 + 1] = R.v[i].y; w[(4 * i) * 65 + 2] = R.v[i].z; w[(4 * i) * 65 + 3] = R.v[i].w; } }
    LDS_WAIT(); asm volatile("" ::: "memory");
    const int c = lane & 7; const bool hg = d.gsel != 0.f;
    const f32x4 one = {1.f, 1.f, 1.f, 1.f}; const f32x4 g0 = hg ? R.g0 : one, g1 = hg ? R.g1 : one;
    if (d.f8) {
#pragma unroll
        for (int j = 0; j < 8; ++j) { const int n = (lane >> 3) + 8 * j; const LAS float* s = scr + (8 * c) * 65 + n; unsigned w0 = 0u, w1 = 0u;
#define W8V(x) __builtin_amdgcn_fmed3f(64.f * (x), -448.f, 448.f)
            w0 = __builtin_amdgcn_cvt_pk_fp8_f32(W8V(s[0 * 65] * g0.x), W8V(s[1 * 65] * g0.y), w0, false); w0 = __builtin_amdgcn_cvt_pk_fp8_f32(W8V(s[2 * 65] * g0.z), W8V(s[3 * 65] * g0.w), w0, true);
            w1 = __builtin_amdgcn_cvt_pk_fp8_f32(W8V(s[4 * 65] * g1.x), W8V(s[5 * 65] * g1.y), w1, false); w1 = __builtin_amdgcn_cvt_pk_fp8_f32(W8V(s[6 * 65] * g1.z), W8V(s[7 * 65] * g1.w), w1, true);
#undef W8V
#if (CV_NT & 2)
            __builtin_nontemporal_store((v2u){w0, w1}, (GAS v2u*)(d.dst + (size_t)n * d.pitch + 8 * c)); }
#else
            *(GAS v2u*)(d.dst + (size_t)n * d.pitch + 8 * c) = (v2u){w0, w1}; }
#endif
    } else {
#pragma unroll
        for (int j = 0; j < 8; ++j) { const int n = (lane >> 3) + 8 * j; const LAS float* s = scr + (8 * c) * 65 + n;
            v4u o; o.x = pk2(s[0 * 65] * g0.x, s[1 * 65] * g0.y); o.y = pk2(s[2 * 65] * g0.z, s[3 * 65] * g0.w); o.z = pk2(s[4 * 65] * g1.x, s[5 * 65] * g1.y); o.w = pk2(s[6 * 65] * g1.z, s[7 * 65] * g1.w);
#if (CV_NT & 2)
            __builtin_nontemporal_store(o, (GAS v4u*)(d.dst + (size_t)n * d.pitch + 16 * c)); }
#else
            *(GAS v4u*)(d.dst + (size_t)n * d.pitch + 16 * c) = o; }
#endif
    }
    LDS_WAIT(); asm volatile("" ::: "memory");
}
template <int NI>
__device__ __forceinline__ void convert_run(int start, int step, const CAS Args* ap, unsigned char* ws, LAS float* scr, int lane) {
    static_assert(NI >= 2 && NI % 2 == 0, "even item count");
    CvRegs ra, rb; CvDesc da = cv_decode(start, ap, ws), db; cv_load(da, lane, ra);
#pragma unroll
    for (int k = 0; k + 2 < NI; k += 2) {
        db = cv_decode(start + (k + 1) * step, ap, ws); cv_load(db, lane, rb);
        cv_finish(da, lane, ra, scr);
        da = cv_decode(start + (k + 2) * step, ap, ws); cv_load(da, lane, ra);
        cv_finish(db, lane, rb, scr);
    }
    db = cv_decode(start + (NI - 1) * step, ap, ws); cv_load(db, lane, rb);
    cv_finish(da, lane, ra, scr);
    cv_finish(db, lane, rb, scr);
}
__device__ __forceinline__ void convert_run_n(int start, int n, const CAS Args* ap, unsigned char* ws, LAS float* scr, int lane) {
    CvRegs ra, rb; CvDesc da = cv_decode(start, ap, ws), db; cv_load(da, lane, ra);
#pragma unroll 1
    for (int k = 0; k + 2 < n; k += 2) {
        db = cv_decode(start + k + 1, ap, ws); cv_load(db, lane, rb);
        cv_finish(da, lane, ra, scr);
        da = cv_decode(start + k + 2, ap, ws); cv_load(da, lane, ra);
        cv_finish(db, lane, rb, scr);
    }
    db = cv_decode(start + n - 1, ap, ws); cv_load(db, lane, rb);
    cv_finish(da, lane, ra, scr);
    cv_finish(db, lane, rb, scr);
}
#ifndef CV_RUN
#define CV_RUN 16
#endif
__device__ __forceinline__ bool convert_long(gu32* qv, int first, int nitems, const CAS Args* ap, unsigned char* ws, LAS float* scr, int lane) {
    int base = 0; if (lane == 0) base = (int)__hip_atomic_fetch_add(qv, (unsigned)CV_RUN, RLX_AGENT);
    base = __builtin_amdgcn_readfirstlane(base);
    if (base >= nitems) return false;
    const int n = nitems - base < CV_RUN ? nitems - base : CV_RUN;
    convert_run_n(first + base, n, ap, ws, scr, lane);
    return true;
}
#ifndef CV_R
#define CV_R 4
#endif
__device__ __forceinline__ bool convert_some(gu32* qv, int first, int nitems, const CAS Args* ap, unsigned char* ws, LAS float* scr, int lane) {
    int base = 0; if (lane == 0) base = (int)__hip_atomic_fetch_add(qv, (unsigned)CV_R, RLX_AGENT);
    base = __builtin_amdgcn_readfirstlane(base);
    if (base >= nitems) return false;
    convert_run<CV_R>(first + base, 1, ap, ws, scr, lane);
    return true;
}


__global__ void __launch_bounds__(NWAVES * 64, 2) mega_fwd(Args args) {
    extern __shared__ __attribute__((aligned(16))) unsigned char lds_raw[];
    LAS unsigned char* lds = (LAS unsigned char*)lds_raw;
    volatile LAS unsigned* MISC = (volatile LAS unsigned*)(lds + MISC_OFF);
    const int wave = __builtin_amdgcn_readfirstlane((int)threadIdx.x >> 6);
#define PHASE_TID() int tid = threadIdx.x; asm volatile("" : "+v"(tid)); const int lane = tid & 63; (void)lane
    const int G = gridDim.x; const int bx = blockIdx.x;
    const int vcu = (G % 8 == 0) ? (bx % 8) * (G / 8) + bx / 8 : bx;
    gu32* ctl = (gu32*)(args.ws + WS_CTL);
    for (int u = threadIdx.x; u < (LDS_BYTES - LDSCTL_OFF) / 4; u += NWAVES * 64) ((LAS unsigned*)(lds + LDSCTL_OFF))[u] = 0u;
    __syncthreads();
    const int lo = args.ph_lo, hi_ph = args.ph_hi;
    const bool use_bar = (hi_ph - lo) > 1;
    XcdBarrier bar; bar.bar = (unsigned*)(ctl + CW_BAR); bar.x = 0; bar.st = nullptr;
    if (use_bar) bar = xcd_barrier_post((unsigned*)(ctl + CW_BAR), MISC + 8);
#ifndef ATT_EN
#define ATT_EN 7
#endif
#ifndef ATT_REP
#define ATT_REP 0
#endif
#ifndef PHMASK
#define PHMASK 0x3ff
#endif
#define EN(k) (((PHMASK) >> (k)) & 1)
#ifndef PHREP
#define PHREP 0
#endif
#define REP(k) (((PHREP) >> (k)) & 1)
#define IN(k) (lo <= (k) && (k) < hi_ph)
#define SEAM(k) do { if (IN(k) && IN((k) + 1)) xcd_barrier(bar); } while (0)
#define CAS __attribute__((address_space(4)))
#define INP(k) ((const float*)(const GAS float*)ap->in[k])
#define PHASE_PTRS() const CAS Args* ap = (const CAS Args*)__builtin_amdgcn_kernarg_segment_ptr(); asm volatile("" : "+s"(ap)); unsigned char* const ws = (unsigned char*)(GAS unsigned char*)ap->ws; \
    bf16* const Hb = (bf16*)(ws + WS_H); bf16* const PROJ = (bf16*)(ws + WS_PROJ); bf16* const ACT = (bf16*)(ws + WS_PROJ); bf16* const MIX = (bf16*)(ws + WS_MIX); \
    bf16* const CO = (bf16*)(ws + WS_CO); float* const LSE = (float*)(ws + WS_LSE); bf16* const X0 = (bf16*)(ws + WS_X0); bf16* const X1 = (bf16*)(ws + WS_X1); float* const SCRA = (float*)(ws + WS_SCRA); \
    const bf16* wl = (const bf16*)(ws + WS_W + (size_t)l * WSZ_LAYER); \
    const bf16* W_IN = wl; const bf16* W_OUT = (const bf16*)((const char*)wl + WSZ_WIN); const bf16* W_GU = (const bf16*)((const char*)wl + WSZ_WIN + WSZ_WOUT); const bf16* W_DN = (const bf16*)((const char*)wl + WSZ_WIN + WSZ_WOUT + WSZ_WGU); \
    float* const SSQ = (float*)(ws + WS_CTL) + CW_SS; float* const PSQ = (float*)(ws + WS_PS); (void)SSQ; (void)PSQ; \
    float* const xout = (float*)(GAS float*)ap->out; \
    (void)Hb; (void)PROJ; (void)ACT; (void)MIX; (void)CO; (void)LSE; (void)X0; (void)X1; (void)SCRA; (void)W_IN; (void)W_OUT; (void)W_GU; (void)W_DN; (void)xout
    const int gw = vcu * NWAVES + wave, NGW = G * NWAVES;

    for (int rep_ = 0; rep_ < 1 + REP(0); ++rep_) if (EN(0) && IN(0)) { PHASE_TID(); const CAS Args* ap = (const CAS Args*)__builtin_amdgcn_kernarg_segment_ptr(); asm volatile("" : "+s"(ap)); unsigned char* const ws = (unsigned char*)(GAS unsigned char*)ap->ws;
        LAS float* scr = (LAS float*)(lds + RING_OFF + wave * 16640);
        static_assert(I_IN % (256 * NWAVES * 2) == 0, "prologue items per wave");
        if (NGW == 256 * NWAVES) convert_run<I_IN / (256 * NWAVES)>(gw, NGW, ap, ws, scr, lane);
        else for (int it = 2 * gw; it < I_IN; it += 2 * NGW) convert_run<2>(it, 1, ap, ws, scr, lane);
        { bf16* const Hb = (bf16*)(ws + WS_X0); float* const SSQ = (float*)(ws + WS_CTL) + CW_SS; const float* x0 = INP(0);
          for (int m = gw; m < M; m += NGW) {
            const GAS f32x4* xr = (const GAS f32x4*)(x0 + (size_t)m * D) + lane; f32x4 v[16]; float s = 0.f;
#pragma unroll
            for (int j = 0; j < 16; ++j) { v[j] = xr[64 * j]; s += (v[j].x * v[j].x + v[j].y * v[j].y) + (v[j].z * v[j].z + v[j].w * v[j].w); }
            s = wave_sum(s); if (lane == 0) SSQ[m] = s;
            GAS v2u* o8 = (GAS v2u*)(Hb + (size_t)m * D) + lane;
#pragma unroll
            for (int j = 0; j < 16; ++j) { v2u w; w.x = pk2(v[j].x, v[j].y); w.y = pk2(v[j].z, v[j].w); o8[64 * j] = w; }
          } }
    }
    SEAM(0);
    {
        constexpr int l = 0;
        const int pb = 1 + NPH_LAYER * l;
        for (int rep_ = 0; rep_ < 1 + REP(1); ++rep_) if (EN(1) && IN(pb + 0)) { PHASE_TID(); PHASE_PTRS();
            pg8::Gemm g{X0, W_IN, M, INW, D}; pg8::StaticOrder S; S.init(M, INW, G, (int)blockIdx.x);
            const float* psrc = (l == 0) ? SSQ : PSQ + (size_t)(2 * l - 1) * M * 64; const int pnp = (l == 0) ? 1 : 64;
            pg8::Unit u0; (void)S.next(0, u0); build_rstab(lds, psrc, pnp, u0.pm, tid);
            pg8::EpiProj E{PROJ, INW, pg8::RowScale{(const LAS float*)(lds + RSTAB_OFF), u0.pm, psrc, pnp}, INP(3) + l * 128, INP(4) + l * 128, INP(10) + l * 128, INP(11) + l * 128, INP(14) + l * 128, INP(15) + l * 128, QSCALE, (LAS float*)(lds + 131072)};
            pg8::gemm_phase<pg8::EpiProj, pg8::StaticOrder, true, true>(lds + RING_OFF, g, S, E);
        }
        SEAM(pb + 0);
        for (int rep_ = 0; rep_ < 1 + REP(2); ++rep_) if (EN(2) && IN(pb + 1)) { PHASE_TID(); PHASE_PTRS();
            using namespace att;
            const int wid = wave;
            float shA, shB, shC, bAu;
            { float ga = fmaxf(fabsf(INP(3)[l * 128 + lane]), fabsf(INP(3)[l * 128 + 64 + lane])), gk = fmaxf(fabsf(INP(4)[l * 128 + lane]), fabsf(INP(4)[l * 128 + 64 + lane]));
              float gb = fmaxf(fabsf(INP(10)[l * 128 + lane]), fabsf(INP(10)[l * 128 + 64 + lane])), gkb = fmaxf(fabsf(INP(11)[l * 128 + lane]), fabsf(INP(11)[l * 128 + 64 + lane]));
              float gc = fmaxf(fabsf(INP(14)[l * 128 + lane]), fabsf(INP(14)[l * 128 + 64 + lane])), gkc = fmaxf(fabsf(INP(15)[l * 128 + lane]), fabsf(INP(15)[l * 128 + 64 + lane]));
              float rb = 0.f; for (int e = lane; e < 12 * 15 * 31; e += 64) rb = fmaxf(rb, fabsf(INP(12)[(size_t)l * 12 * 15 * 31 + e]));
              ga = wave_max_sw(ga); gk = wave_max_sw(gk); gb = wave_max_sw(gb); gkb = wave_max_sw(gkb); gc = wave_max_sw(gc); gkc = wave_max_sw(gkc); rb = wave_max_sw(rb);
              const float bA = 128.f * QSCALE * ga * gk, bB = 128.f * QSCALE * gb * gkb + rb * LOG2E, bC = 128.f * QSCALE * gc * gkc;
              shA = bA > 64.f ? bA : 0.f; shB = bB > 64.f ? bB : 0.f; shC = bC > 64.f ? bC : 0.f;
              bAu = __int_as_float(__builtin_amdgcn_readfirstlane(__float_as_int(bA)));
              shA = __int_as_float(__builtin_amdgcn_readfirstlane(__float_as_int(shA))); shB = __int_as_float(__builtin_amdgcn_readfirstlane(__float_as_int(shB))); shC = __int_as_float(__builtin_amdgcn_readfirstlane(__float_as_int(shC))); }
            ALAS char* al = (ALAS char*)(lds + RING_OFF);
            gu32* const cvq = ctl + CW_Q + 64 * (4 + l);
            constexpr int cv_first = (l == 0) ? I_IN : I_LAYER + I_IN, cv_n = (l == 0) ? I_LAYER : I_LAYER - I_IN;
            static_assert(cv_n % CV_R == 0 && cv_first % 1 == 0, "queue length is a multiple of the per-visit item count");
#ifdef CV_SUBSET
#define CONVERT_FILL() do {} while (0)
#else
#define CONVERT_FILL() (void)convert_some(cvq, cv_first, cv_n, ap, ws, (LAS float*)(lds + RING_OFF + wave * 16640), tid & 63)
#endif
            const bool roles = (G == 256);
            const int xcd_ = vcu >> 5, li_ = vcu & 31, aj_ = (li_ >> 2) * 3 + (li_ & 3);
            const bool cvrole = roles && ((li_ & 3) == 3);
            if (cvrole) { while (convert_long(cvq, cv_first, cv_n, ap, ws, (LAS float*)(lds + RING_OFF + wave * 16640), tid & 63)) {} __syncthreads(); }
            const int nA_ = !roles ? (256 - vcu + G - 1) / G : cvrole ? 0 : aj_ < 16 ? 1 : 2;
            for (int rep2_ = 0; rep2_ < 1 + (ATT_REP & 1); ++rep2_) if (ATT_EN & 1) for (int ka_ = 0; ka_ < nA_; ++ka_) {
                asm volatile("" : "+v"(tid)); const int lane = tid & 63, r32 = lane & 31, hi = lane >> 5;
                int ua;
                if (roles) { const int hh = aj_ < 16 ? 2 + (aj_ >> 3) : 1 - ka_, qq = (xcd_ & 3) * 8 + (aj_ < 16 ? (aj_ & 7) : aj_ - 16); ua = ((xcd_ >> 2) << 7) + (hh << 5) + qq; }
                else { const int ua_ = vcu + ka_ * G; ua = ((ua_ >> 7) << 7) + (((ua_ >> 3) & 3) << 5) + (((ua_ >> 5) & 3) << 3) + (ua_ & 7); }
                const int b = ua >> 7, h = (ua >> 5) & 3, qb = ua & 31;
                const float lam_init = 0.8f - 0.6f * __builtin_amdgcn_exp2f(-0.3f * LOG2E * (float)l);
                float d1 = 0.f, d2 = 0.f;
                { const float* q1 = INP(5) + l * 128; const float* k1 = INP(6) + l * 128; const float* q2 = INP(7) + l * 128; const float* k2 = INP(8) + l * 128;
                  d1 = q1[lane] * k1[lane] + q1[lane + 64] * k1[lane + 64]; d2 = q2[lane] * k2[lane] + q2[lane + 64] * k2[lane + 64]; d1 = wave_sum_sw(d1); d2 = wave_sum_sw(d2); }
                const float lam = __builtin_amdgcn_exp2f(d1 * LOG2E) - __builtin_amdgcn_exp2f(d2 * LOG2E) + lam_init;
                const int wq = wid & 3, vh = wid >> 2;
                const int qtok = qb * 128 + wq * 32 + r32;
                const float slL = __builtin_amdgcn_exp2f(-2.0f * (float)(h + 1)) * LOG2E;
                const int Dh = (int)fminf((2.02f * bAu + 151.0f) / slL, 8192.0f) + 1;
                const int jlo = max(0, (qb * 128 - Dh) >> 6), jhi = min(SEQ / 64 - 1, (qb * 128 + 127 + Dh) >> 6);
                for (int pass = 0; pass < 2; ++pass) {
                    TileParams tp;
                    tp.qrow = PROJ + (size_t)(b * SEQ + qtok) * PITCH + C_QA + h * 256 + pass * 128 + hi * 8;
                    tp.kp = PROJ + (size_t)(b * SEQ + jlo * 64) * PITCH + C_KA + h * 256 + pass * 128;
                    tp.vp = PROJ + (size_t)(b * SEQ + jlo * 64) * PITCH + C_VA + h * 256;
                    tp.kstride = PITCH; tp.nt = jhi - jlo + 1; tp.jact_lo = 0; tp.jact_hi = SEQ / 64;
                    tp.fa = (float)(qtok - 4 * hi - 64 * jlo); tp.slope = slL; tp.tb = 0; tp.ucs = 0; tp.sh = shA;
                    f32x16 o[4]; float l_reg = 0.f;
#pragma unroll
                    for (int d = 0; d < 4; ++d) for (int r = 0; r < 16; ++r) o[d][r] = 0.f;
                    attn_tiles_A(al, tp, o, l_reg, tid);
                    int te = threadIdx.x; asm volatile("" : "+v"(te)); const int le = te & 63, r32 = le & 31, hi = le >> 5;
                    { float rli[16]; row_bcast(al, wid, r32, hi, __builtin_amdgcn_rcpf(l_reg), rli);
#pragma unroll
                      for (int d = 0; d < 4; ++d)
#pragma unroll
                          for (int r = 0; r < 16; ++r) o[d][r] *= rli[r]; }
                    float* scr = SCRA + (((size_t)ua * 8 + wid) * 64 + le) * 64;
                    const int obase = (b * SEQ + qb * 128 + wq * 32) * DM + h * 256 + vh * 128 + r32;
                    if (pass == 0) {
#pragma unroll
                        for (int d = 0; d < 4; ++d) {
#pragma unroll
                            for (int r = 0; r < 16; r += 4) *(GAS f32x4*)(scr + d * 16 + r) = (f32x4){o[d][r], o[d][r + 1], o[d][r + 2], o[d][r + 3]};
                            asm volatile("" ::: "memory"); }
                    } else {
                        ALAS float* ssx = (ALAS float*)(al + OFF_SSX);
                        float ss[16];
#pragma unroll
                        for (int d = 0; d < 4; ++d) {
#pragma unroll
                            for (int r = 0; r < 16; r += 4) { const f32x4 t = *(const GAS f32x4*)(scr + d * 16 + r);
#pragma unroll
                                for (int q = 0; q < 4; ++q) o[d][r + q] = t[q] - lam * o[d][r + q]; }
                            asm volatile("" ::: "memory"); }
#pragma unroll
                        for (int r = 0; r < 16; ++r) { float s = 0.f;
#pragma unroll
                            for (int d = 0; d < 4; ++d) s += o[d][r] * o[d][r];
                            ss[r] = half_sum(s); }
                        if (r32 == 0) {
#pragma unroll
                            for (int r = 0; r < 16; ++r) ssx[wid * 32 + crow(r, hi)] = ss[r]; }
                        __syncthreads();
                        const float* go = INP(9) + (size_t)l * 256 + vh * 128;
                        const float osc = 1.0f - lam_init;
#pragma unroll
                        for (int r = 0; r < 16; ++r) { const int row = crow(r, hi); const float tot = ss[r] + ssx[(wid ^ 4) * 32 + row];
                            const float rs = (__builtin_amdgcn_rsqf(tot * (1.f / 256.f) + RMS_EPS)) * osc;
                            bf16* orow = MIX + (size_t)(obase + row * DM);
#pragma unroll
                            for (int d = 0; d < 4; ++d) orow[d * 32] = att::f2bf(o[d][r] * rs * go[d * 32 + r32]); }
                        __syncthreads();
                    }
                }
            }
            if (ATT_EN & 2) {
                gu32* qhead = ctl + CW_Q + 64 * (2 * l);
                volatile LAS unsigned* qslot = MISC + 16;
                unsigned nxt = 0u;
                if (tid == 0) nxt = __hip_atomic_fetch_add(qhead, 1u, RLX_AGENT);
                for (;;) {
                    if (tid == 0) qslot[0] = nxt;
                    __syncthreads();
                    const int ub = (int)qslot[0];
                    __syncthreads();
                    if (ub >= 384) break;
                    if (tid == 0) nxt = __hip_atomic_fetch_add(qhead, 1u, RLX_AGENT);
                    asm volatile("" : "+v"(tid)); const int lane = tid & 63, r32 = lane & 31, hi = lane >> 5;
                    const int b = ub / 192, h = (ub / 16) % 12, rg = ub % 16, r0 = 4 * rg;
                    const int i0 = min(max(r0 - 4, 0), 56), i1 = min(max(r0 + 3 - 4, 0), 56) + 7;
                    { ALAS float* tab = (ALAS float*)(al + OFF_TAB); const float* rp = INP(12) + ((size_t)l * 12 + h) * 15 * 31;
                      for (int e = tid; e < 15 * 128; e += NWAVES * 64) { const int dr = e >> 7, x = (e & 127) - 48; tab[e] = (x >= 0 && x < 31) ? rp[dr * 31 + x] * LOG2E - shB : 0.f; } }
                    const int rq = r0 + (wid >> 1), c = (wid & 1) * 32 + r32;
                    const int rs_ = min(max(rq - 4, 0), 56), cs = min(max(c - 8, 0), 48);
                    TileParams tp;
                    tp.qrow = PROJ + (size_t)(b * SEQ + r0 * 64 + wid * 32 + r32) * PITCH + C_QB + h * 128 + hi * 8;
                    tp.kp = PROJ + (size_t)(b * SEQ + i0 * 64) * PITCH + C_KB + h * 128;
                    tp.vp = PROJ + (size_t)(b * SEQ + i0 * 64) * PITCH + C_VB + h * 128;
                    tp.kstride = PITCH; tp.nt = i1 - i0 + 1; tp.jact_lo = rs_ - i0; tp.jact_hi = rs_ + 7 - i0;
                    tp.fa = 0.f; tp.slope = 0.f; tp.tb = (i0 - rq + 7) * 128 + 48 + 15 + 4 * hi - c; tp.ucs = 4 * hi - cs; tp.sh = shB;
                    f32x16 o[4]; float l_reg = 0.f;
#pragma unroll
                    for (int d = 0; d < 4; ++d) for (int r = 0; r < 16; ++r) o[d][r] = 0.f;
                    attn_tiles<1>(al, tp, o, l_reg, tid);
                    float rli[16]; row_bcast(al, wid, r32, hi, __builtin_amdgcn_rcpf(l_reg), rli);
                    const float* go = INP(13) + (size_t)l * 128;
#pragma unroll
                    for (int r = 0; r < 16; ++r) { float s = 0.f; float v[4];
#pragma unroll
                        for (int d = 0; d < 4; ++d) { v[d] = o[d][r] * rli[r]; s += v[d] * v[d]; }
                        s = half_sum(s); const float rs = __builtin_amdgcn_rsqf(s * (1.f / 128.f) + RMS_EPS);
                        bf16* orow = MIX + (size_t)(b * SEQ + r0 * 64 + wid * 32 + crow(r, hi)) * DM + 1024 + h * 128 + r32;
#pragma unroll
                        for (int d = 0; d < 4; ++d) orow[d * 32] = att::f2bf(v[d] * rs * go[d * 32 + r32]); }
                    __syncthreads();
#ifdef CV_FILL
                    CONVERT_FILL();
#endif
                }
            }
            if (ATT_EN & 4) {
                gu32* qhead = ctl + CW_Q + 64 * (2 * l + 1);
                volatile LAS unsigned* qslot = MISC + 16;
                unsigned nxt = 0u;
                if (tid == 0) nxt = __hip_atomic_fetch_add(qhead, 1u, RLX_AGENT);
                for (;;) {
                    if (tid == 0) qslot[0] = nxt;
                    __syncthreads();
                    const int uc = (int)qslot[0];
                    __syncthreads();
                    if (uc >= 1152) break;
                    if (tid == 0) nxt = __hip_atomic_fetch_add(qhead, 1u, RLX_AGENT);
                    asm volatile("" : "+v"(tid)); const int lane = tid & 63, r32 = lane & 31, hi = lane >> 5;
                    const int b = uc / 576, h = (uc / 48) % 12, x = uc % 48, gbr = x >> 4, idx = x & 15;
                    const int dil = gbr == 0 ? 1 : gbr == 1 ? 4 : 16, L = SEQ / dil;
                    const int rho = gbr == 0 ? 0 : gbr == 1 ? (idx >> 2) : idx, u0 = gbr == 0 ? idx * 256 : gbr == 1 ? (idx & 3) * 256 : 0;
                    const int jlo = (u0 == 0) ? 1 : 0, jhi = (u0 + 256 >= L) ? 4 : 5;
                    const int i_ = wid * 32 + r32;
                    TileParams tp;
                    tp.qrow = PROJ + (size_t)(b * SEQ + (u0 + i_) * dil + rho) * PITCH + C_QC + h * 128 + hi * 8;
                    const int uk0 = u0 - 64 + 64 * jlo;
                    tp.kp = PROJ + (size_t)(b * SEQ + uk0 * dil + rho) * PITCH + C_KC + h * 128;
                    tp.vp = PROJ + (size_t)(b * SEQ + uk0 * dil + rho) * PITCH + C_VC + h * 128;
                    tp.kstride = (size_t)PITCH * dil; tp.nt = jhi - jlo + 1; tp.jact_lo = (wid >> 1) - jlo; tp.jact_hi = (wid >> 1) + 2 - jlo;
                    tp.fa = (float)(i_ + 64 - 64 * jlo - 4 * hi); tp.slope = __builtin_amdgcn_exp2f((float)(h + 1) * (-8.0f / 12.0f)) * LOG2E * (float)dil; tp.tb = 0; tp.ucs = 0; tp.sh = shC;
                    f32x16 o[4]; float l_reg = 0.f;
#pragma unroll
                    for (int d = 0; d < 4; ++d) for (int r = 0; r < 16; ++r) o[d][r] = 0.f;
                    attn_tiles<2>(al, tp, o, l_reg, tid);
                    float rli[16]; row_bcast(al, wid, r32, hi, __builtin_amdgcn_rcpf(l_reg), rli);
                    bf16* cog = CO + (size_t)gbr * M * 1536;
#pragma unroll
                    for (int r = 0; r < 16; ++r) { bf16* orow = cog + (size_t)(b * SEQ + (u0 + wid * 32 + crow(r, hi)) * dil + rho) * 1536 + h * 128 + r32;
#pragma unroll
                        for (int d = 0; d < 4; ++d) orow[d * 32] = att::f2bf(o[d][r] * rli[r]); }
                    if (hi == 0) LSE[((size_t)gbr * M + b * SEQ + (u0 + i_) * dil + rho) * 12 + h] = __builtin_amdgcn_logf(l_reg);
                    __syncthreads();
#ifdef CV_FILL
                    CONVERT_FILL();
#endif
                }
            }
#ifdef CV_SUBSET
            if ((vcu % CV_SUBSET) == 0)
#endif
            while (convert_some(cvq, cv_first, cv_n, ap, ws, (LAS float*)(lds + RING_OFF + wave * 16640), tid & 63)) {}
        }
        SEAM(pb + 1);
        for (int rep_ = 0; rep_ < 1 + REP(3); ++rep_) if (EN(3) && IN(pb + 2)) { PHASE_TID(); PHASE_PTRS();
            const int hs = lane >> 4, sub = lane & 15;
            const float* go = INP(16) + (size_t)l * 128 + sub * 8;
            const f32x4 g0 = *(const GAS f32x4*)go, g1 = *(const GAS f32x4*)(go + 4);
            for (int it = gw; it < (M / 4) * 3; it += NGW) {
                const int rg = it / 3, ch = it - rg * 3, h = ch * 4 + hs;
                float ls[4][3]; v4u w[4][3];
#pragma unroll
                for (int q4 = 0; q4 < 4; ++q4)
#pragma unroll
                    for (int g = 0; g < 3; ++g) { const size_t row = (size_t)rg * 4 + q4; ls[q4][g] = LSE[((size_t)g * M + row) * 12 + h]; w[q4][g] = *(const GAS v4u*)(CO + ((size_t)g * M + row) * 1536 + h * 128 + sub * 8); }
#pragma unroll
                for (int q4 = 0; q4 < 4; ++q4) {
                    const float mx = fmaxf(ls[q4][0], fmaxf(ls[q4][1], ls[q4][2]));
                    float e[3], es = 0.f;
#pragma unroll
                    for (int g = 0; g < 3; ++g) { e[g] = __builtin_amdgcn_exp2f(ls[q4][g] - mx); es += e[g]; }
                    const float inv = __builtin_amdgcn_rcpf(es); float x[8];
#pragma unroll
                    for (int q = 0; q < 8; ++q) x[q] = 0.f;
#pragma unroll
                    for (int g = 0; g < 3; ++g) { const float wg = e[g] * inv; const unsigned ww[4] = {w[q4][g].x, w[q4][g].y, w[q4][g].z, w[q4][g].w};
#pragma unroll
                        for (int q = 0; q < 4; ++q) { x[2 * q] += wg * bflo(ww[q]); x[2 * q + 1] += wg * bfhi(ww[q]); } }
                    float s = 0.f;
#pragma unroll
                    for (int q = 0; q < 8; ++q) s += x[q] * x[q];
                    s += att::swz_xor<1>(s); s += att::swz_xor<2>(s); s += att::swz_xor<4>(s); s += att::swz_xor<8>(s);
                    const float rs = __builtin_amdgcn_rsqf(s * (1.f / 128.f) + RMS_EPS);
                    v4u o; o.x = pk2(x[0] * rs * g0.x, x[1] * rs * g0.y); o.y = pk2(x[2] * rs * g0.z, x[3] * rs * g0.w); o.z = pk2(x[4] * rs * g1.x, x[5] * rs * g1.y); o.w = pk2(x[6] * rs * g1.z, x[7] * rs * g1.w);
                    *(GAS v4u*)(MIX + ((size_t)rg * 4 + q4) * D + 2560 + h * 128 + sub * 8) = o; }
            }
        }
        SEAM(pb + 2);
        for (int rep_ = 0; rep_ < 1 + REP(4); ++rep_) if (EN(4) && IN(pb + 3)) { PHASE_TID(); PHASE_PTRS();
            pg8::Gemm g{MIX, W_OUT, M, D, D}; pg8::StaticOrder S; S.init(M, D, G, (int)blockIdx.x);
            constexpr bool xmix = (MIX_GU >> l) & 1; using ER = pg8::EpiRes<false, xmix ? GU_PITCH : 0, xmix ? GUK8 : 0>;
            ER E{X0, X1, nullptr, xmix ? ws + WS_H : nullptr, D, PSQ + (size_t)(2 * l) * M * 64, 1.0f};
            pg8::gemm_phase<ER, pg8::StaticOrder, true, true>(lds + RING_OFF, g, S, E);
        }
        SEAM(pb + 3);
        for (int rep_ = 0; rep_ < 1 + REP(5); ++rep_) if (EN(5) && IN(pb + 4)) { PHASE_TID(); PHASE_PTRS();
            constexpr int gmode = ((MIX_GU >> l) & 1) ? 2 : 0;
            pg8::Gemm g{gmode == 2 ? (const bf16*)(ws + WS_H) : X1, W_GU, M, 2 * FF, gmode == 2 ? GU_PITCH / 2 : D, gmode == 2 ? GU_T8 : 0}; pg8::StaticOrder S; S.init(M, 2 * FF, G, (int)blockIdx.x);
            const float* psrc = PSQ + (size_t)(2 * l) * M * 64;
            pg8::Unit u0; (void)S.next(0, u0); build_rstab(lds, psrc, 64, u0.pm, tid);
            if ((F8_DOWN >> l) & 1) { pg8::EpiSwiGLU<1> E{ACT, FF, FF, pg8::RowScale{(const LAS float*)(lds + RSTAB_OFF), u0.pm, psrc, 64}};
                pg8::gemm_phase<pg8::EpiSwiGLU<1>, pg8::StaticOrder, true, true, gmode>(lds + RING_OFF, g, S, E); }
            else if ((MIX_DOWN >> l) & 1) { pg8::EpiSwiGLU<2> E{ACT, MIX_PITCH, MIXK8, pg8::RowScale{(const LAS float*)(lds + RSTAB_OFF), u0.pm, psrc, 64}};
                pg8::gemm_phase<pg8::EpiSwiGLU<2>, pg8::StaticOrder, true, true, gmode>(lds + RING_OFF, g, S, E); }
            else { pg8::EpiSwiGLU<0> E{ACT, 2 * FF, 0, pg8::RowScale{(const LAS float*)(lds + RSTAB_OFF), u0.pm, psrc, 64}};
                pg8::gemm_phase<pg8::EpiSwiGLU<0>, pg8::StaticOrder, true, true, gmode>(lds + RING_OFF, g, S, E); }
        }
        SEAM(pb + 4);
        for (int rep_ = 0; rep_ < 1 + REP(6); ++rep_) if (EN(6) && IN(pb + 5)) { PHASE_TID(); PHASE_PTRS();
            constexpr int dmode = ((F8_DOWN >> l) & 1) ? 1 : ((MIX_DOWN >> l) & 1) ? 2 : 0;
            pg8::Gemm g{ACT, W_DN, M, D, dmode == 1 ? FF / 2 : dmode == 2 ? MIX_PITCH / 2 : FF, dmode == 2 ? MIX_T8 : 0}; pg8::StaticOrder S; S.init(M, D, G, (int)blockIdx.x);
            const float asc = dmode == 1 ? 1.0f / (16.0f * 64.0f) : 1.0f;
            if (l + 1 < NLAYER) { pg8::EpiRes<false> E{X1, X0, nullptr, nullptr, D, PSQ + (size_t)(2 * l + 1) * M * 64, asc};
                pg8::gemm_phase<pg8::EpiRes<false>, pg8::StaticOrder, true, true, dmode>(lds + RING_OFF, g, S, E); }
            else { pg8::EpiRes<true> E{X1, nullptr, xout, nullptr, D, nullptr, asc};
                pg8::gemm_phase<pg8::EpiRes<true>, pg8::StaticOrder, true, true, dmode>(lds + RING_OFF, g, S, E); }
        }
        SEAM(pb + 5);
    }
    {
        constexpr int l = 1;
        const int pb = 1 + NPH_LAYER * l;
        for (int rep_ = 0; rep_ < 1 + REP(1); ++rep_) if (EN(1) && IN(pb + 0)) { PHASE_TID(); PHASE_PTRS();
            pg8::Gemm g{X0, W_IN, M, INW, D}; pg8::StaticOrder S; S.init(M, INW, G, (int)blockIdx.x);
            const float* psrc = (l == 0) ? SSQ : PSQ + (size_t)(2 * l - 1) * M * 64; const int pnp = (l == 0) ? 1 : 64;
            pg8::Unit u0; (void)S.next(0, u0); build_rstab(lds, psrc, pnp, u0.pm, tid);
            pg8::EpiProj E{PROJ, INW, pg8::RowScale{(const LAS float*)(lds + RSTAB_OFF), u0.pm, psrc, pnp}, INP(3) + l * 128, INP(4) + l * 128, INP(10) + l * 128, INP(11) + l * 128, INP(14) + l * 128, INP(15) + l * 128, QSCALE, (LAS float*)(lds + 131072)};
            pg8::gemm_phase<pg8::EpiProj, pg8::StaticOrder, true, true>(lds + RING_OFF, g, S, E);
        }
        SEAM(pb + 0);
        for (int rep_ = 0; rep_ < 1 + REP(2); ++rep_) if (EN(2) && IN(pb + 1)) { PHASE_TID(); PHASE_PTRS();
            using namespace att;
            const int wid = wave;
            float shA, shB, shC, bAu;
            { float ga = fmaxf(fabsf(INP(3)[l * 128 + lane]), fabsf(INP(3)[l * 128 + 64 + lane])), gk = fmaxf(fabsf(INP(4)[l * 128 + lane]), fabsf(INP(4)[l * 128 + 64 + lane]));
              float gb = fmaxf(fabsf(INP(10)[l * 128 + lane]), fabsf(INP(10)[l * 128 + 64 + lane])), gkb = fmaxf(fabsf(INP(11)[l * 128 + lane]), fabsf(INP(11)[l * 128 + 64 + lane]));
              float gc = fmaxf(fabsf(INP(14)[l * 128 + lane]), fabsf(INP(14)[l * 128 + 64 + lane])), gkc = fmaxf(fabsf(INP(15)[l * 128 + lane]), fabsf(INP(15)[l * 128 + 64 + lane]));
              float rb = 0.f; for (int e = lane; e < 12 * 15 * 31; e += 64) rb = fmaxf(rb, fabsf(INP(12)[(size_t)l * 12 * 15 * 31 + e]));
              ga = wave_max_sw(ga); gk = wave_max_sw(gk); gb = wave_max_sw(gb); gkb = wave_max_sw(gkb); gc = wave_max_sw(gc); gkc = wave_max_sw(gkc); rb = wave_max_sw(rb);
              const float bA = 128.f * QSCALE * ga * gk, bB = 128.f * QSCALE * gb * gkb + rb * LOG2E, bC = 128.f * QSCALE * gc * gkc;
              shA = bA > 64.f ? bA : 0.f; shB = bB > 64.f ? bB : 0.f; shC = bC > 64.f ? bC : 0.f;
              bAu = __int_as_float(__builtin_amdgcn_readfirstlane(__float_as_int(bA)));
              shA = __int_as_float(__builtin_amdgcn_readfirstlane(__float_as_int(shA))); shB = __int_as_float(__builtin_amdgcn_readfirstlane(__float_as_int(shB))); shC = __int_as_float(__builtin_amdgcn_readfirstlane(__float_as_int(shC))); }
            ALAS char* al = (ALAS char*)(lds + RING_OFF);
            gu32* const cvq = ctl + CW_Q + 64 * (4 + l);
            constexpr int cv_first = (l == 0) ? I_IN : I_LAYER + I_IN, cv_n = (l == 0) ? I_LAYER : I_LAYER - I_IN;
            static_assert(cv_n % CV_R == 0 && cv_first % 1 == 0, "queue length is a multiple of the per-visit item count");
#ifdef CV_SUBSET
#define CONVERT_FILL() do {} while (0)
#else
#define CONVERT_FILL() (void)convert_some(cvq, cv_first, cv_n, ap, ws, (LAS float*)(lds + RING_OFF + wave * 16640), tid & 63)
#endif
            const bool roles = (G == 256);
            const int xcd_ = vcu >> 5, li_ = vcu & 31, aj_ = (li_ >> 2) * 3 + (li_ & 3);
            const bool cvrole = roles && ((li_ & 3) == 3);
            if (cvrole) { while (convert_long(cvq, cv_first, cv_n, ap, ws, (LAS float*)(lds + RING_OFF + wave * 16640), tid & 63)) {} __syncthreads(); }
            const int nA_ = !roles ? (256 - vcu + G - 1) / G : cvrole ? 0 : aj_ < 16 ? 1 : 2;
            for (int rep2_ = 0; rep2_ < 1 + (ATT_REP & 1); ++rep2_) if (ATT_EN & 1) for (int ka_ = 0; ka_ < nA_; ++ka_) {
                asm volatile("" : "+v"(tid)); const int lane = tid & 63, r32 = lane & 31, hi = lane >> 5;
                int ua;
                if (roles) { const int hh = aj_ < 16 ? 2 + (aj_ >> 3) : 1 - ka_, qq = (xcd_ & 3) * 8 + (aj_ < 16 ? (aj_ & 7) : aj_ - 16); ua = ((xcd_ >> 2) << 7) + (hh << 5) + qq; }
                else { const int ua_ = vcu + ka_ * G; ua = ((ua_ >> 7) << 7) + (((ua_ >> 3) & 3) << 5) + (((ua_ >> 5) & 3) << 3) + (ua_ & 7); }
                const int b = ua >> 7, h = (ua >> 5) & 3, qb = ua & 31;
                const float lam_init = 0.8f - 0.6f * __builtin_amdgcn_exp2f(-0.3f * LOG2E * (float)l);
                float d1 = 0.f, d2 = 0.f;
                { const float* q1 = INP(5) + l * 128; const float* k1 = INP(6) + l * 128; const float* q2 = INP(7) + l * 128; const float* k2 = INP(8) + l * 128;
                  d1 = q1[lane] * k1[lane] + q1[lane + 64] * k1[lane + 64]; d2 = q2[lane] * k2[lane] + q2[lane + 64] * k2[lane + 64]; d1 = wave_sum_sw(d1); d2 = wave_sum_sw(d2); }
                const float lam = __builtin_amdgcn_exp2f(d1 * LOG2E) - __builtin_amdgcn_exp2f(d2 * LOG2E) + lam_init;
                const int wq = wid & 3, vh = wid >> 2;
                const int qtok = qb * 128 + wq * 32 + r32;
                const float slL = __builtin_amdgcn_exp2f(-2.0f * (float)(h + 1)) * LOG2E;
                const int Dh = (int)fminf((2.02f * bAu + 151.0f) / slL, 8192.0f) + 1;
                const int jlo = max(0, (qb * 128 - Dh) >> 6), jhi = min(SEQ / 64 - 1, (qb * 128 + 127 + Dh) >> 6);
                for (int pass = 0; pass < 2; ++pass) {
                    TileParams tp;
                    tp.qrow = PROJ + (size_t)(b * SEQ + qtok) * PITCH + C_QA + h * 256 + pass * 128 + hi * 8;
                    tp.kp = PROJ + (size_t)(b * SEQ + jlo * 64) * PITCH + C_KA + h * 256 + pass * 128;
                    tp.vp = PROJ + (size_t)(b * SEQ + jlo * 64) * PITCH + C_VA + h * 256;
                    tp.kstride = PITCH; tp.nt = jhi - jlo + 1; tp.jact_lo = 0; tp.jact_hi = SEQ / 64;
                    tp.fa = (float)(qtok - 4 * hi - 64 * jlo); tp.slope = slL; tp.tb = 0; tp.ucs = 0; tp.sh = shA;
                    f32x16 o[4]; float l_reg = 0.f;
#pragma unroll
                    for (int d = 0; d < 4; ++d) for (int r = 0; r < 16; ++r) o[d][r] = 0.f;
                    attn_tiles_A(al, tp, o, l_reg, tid);
                    int te = threadIdx.x; asm volatile("" : "+v"(te)); const int le = te & 63, r32 = le & 31, hi = le >> 5;
                    { float rli[16]; row_bcast(al, wid, r32, hi, __builtin_amdgcn_rcpf(l_reg), rli);
#pragma unroll
                      for (int d = 0; d < 4; ++d)
#pragma unroll
                          for (int r = 0; r < 16; ++r) o[d][r] *= rli[r]; }
                    float* scr = SCRA + (((size_t)ua * 8 + wid) * 64 + le) * 64;
                    const int obase = (b * SEQ + qb * 128 + wq * 32) * DM + h * 256 + vh * 128 + r32;
                    if (pass == 0) {
#pragma unroll
                        for (int d = 0; d < 4; ++d) {
#pragma unroll
                            for (int r = 0; r < 16; r += 4) *(GAS f32x4*)(scr + d * 16 + r) = (f32x4){o[d][r], o[d][r + 1], o[d][r + 2], o[d][r + 3]};
                            asm volatile("" ::: "memory"); }
                    } else {
                        ALAS float* ssx = (ALAS float*)(al + OFF_SSX);
                        float ss[16];
#pragma unroll
                        for (int d = 0; d < 4; ++d) {
#pragma unroll
                            for (int r = 0; r < 16; r += 4) { const f32x4 t = *(const GAS f32x4*)(scr + d * 16 + r);
#pragma unroll
                                for (int q = 0; q < 4; ++q) o[d][r + q] = t[q] - lam * o[d][r + q]; }
                            asm volatile("" ::: "memory"); }
#pragma unroll
                        for (int r = 0; r < 16; ++r) { float s = 0.f;
#pragma unroll
                            for (int d = 0; d < 4; ++d) s += o[d][r] * o[d][r];
                            ss[r] = half_sum(s); }
                        if (r32 == 0) {
#pragma unroll
                            for (int r = 0; r < 16; ++r) ssx[wid * 32 + crow(r, hi)] = ss[r]; }
                        __syncthreads();
                        const float* go = INP(9) + (size_t)l * 256 + vh * 128;
                        const float osc = 1.0f - lam_init;
#pragma unroll
                        for (int r = 0; r < 16; ++r) { const int row = crow(r, hi); const float tot = ss[r] + ssx[(wid ^ 4) * 32 + row];
                            const float rs = (__builtin_amdgcn_rsqf(tot * (1.f / 256.f) + RMS_EPS)) * osc;
                            bf16* orow = MIX + (size_t)(obase + row * DM);
#pragma unroll
                            for (int d = 0; d < 4; ++d) orow[d * 32] = att::f2bf(o[d][r] * rs * go[d * 32 + r32]); }
                        __syncthreads();
                    }
                }
            }
            if (ATT_EN & 2) {
                gu32* qhead = ctl + CW_Q + 64 * (2 * l);
                volatile LAS unsigned* qslot = MISC + 16;
                unsigned nxt = 0u;
                if (tid == 0) nxt = __hip_atomic_fetch_add(qhead, 1u, RLX_AGENT);
                for (;;) {
                    if (tid == 0) qslot[0] = nxt;
                    __syncthreads();
                    const int ub = (int)qslot[0];
                    __syncthreads();
                    if (ub >= 384) break;
                    if (tid == 0) nxt = __hip_atomic_fetch_add(qhead, 1u, RLX_AGENT);
                    asm volatile("" : "+v"(tid)); const int lane = tid & 63, r32 = lane & 31, hi = lane >> 5;
                    const int b = ub / 192, h = (ub / 16) % 12, rg = ub % 16, r0 = 4 * rg;
                    const int i0 = min(max(r0 - 4, 0), 56), i1 = min(max(r0 + 3 - 4, 0), 56) + 7;
                    { ALAS float* tab = (ALAS float*)(al + OFF_TAB); const float* rp = INP(12) + ((size_t)l * 12 + h) * 15 * 31;
                      for (int e = tid; e < 15 * 128; e += NWAVES * 64) { const int dr = e >> 7, x = (e & 127) - 48; tab[e] = (x >= 0 && x < 31) ? rp[dr * 31 + x] * LOG2E - shB : 0.f; } }
                    const int rq = r0 + (wid >> 1), c = (wid & 1) * 32 + r32;
                    const int rs_ = min(max(rq - 4, 0), 56), cs = min(max(c - 8, 0), 48);
                    TileParams tp;
                    tp.qrow = PROJ + (size_t)(b * SEQ + r0 * 64 + wid * 32 + r32) * PITCH + C_QB + h * 128 + hi * 8;
                    tp.kp = PROJ + (size_t)(b * SEQ + i0 * 64) * PITCH + C_KB + h * 128;
                    tp.vp = PROJ + (size_t)(b * SEQ + i0 * 64) * PITCH + C_VB + h * 128;
                    tp.kstride = PITCH; tp.nt = i1 - i0 + 1; tp.jact_lo = rs_ - i0; tp.jact_hi = rs_ + 7 - i0;
                    tp.fa = 0.f; tp.slope = 0.f; tp.tb = (i0 - rq + 7) * 128 + 48 + 15 + 4 * hi - c; tp.ucs = 4 * hi - cs; tp.sh = shB;
                    f32x16 o[4]; float l_reg = 0.f;
#pragma unroll
                    for (int d = 0; d < 4; ++d) for (int r = 0; r < 16; ++r) o[d][r] = 0.f;
                    attn_tiles<1>(al, tp, o, l_reg, tid);
                    float rli[16]; row_bcast(al, wid, r32, hi, __builtin_amdgcn_rcpf(l_reg), rli);
                    const float* go = INP(13) + (size_t)l * 128;
#pragma unroll
                    for (int r = 0; r < 16; ++r) { float s = 0.f; float v[4];
#pragma unroll
                        for (int d = 0; d < 4; ++d) { v[d] = o[d][r] * rli[r]; s += v[d] * v[d]; }
                        s = half_sum(s); const float rs = __builtin_amdgcn_rsqf(s * (1.f / 128.f) + RMS_EPS);
                        bf16* orow = MIX + (size_t)(b * SEQ + r0 * 64 + wid * 32 + crow(r, hi)) * DM + 1024 + h * 128 + r32;
#pragma unroll
                        for (int d = 0; d < 4; ++d) orow[d * 32] = att::f2bf(v[d] * rs * go[d * 32 + r32]); }
                    __syncthreads();
#ifdef CV_FILL
                    CONVERT_FILL();
#endif
                }
            }
            if (ATT_EN & 4) {
                gu32* qhead = ctl + CW_Q + 64 * (2 * l + 1);
                volatile LAS unsigned* qslot = MISC + 16;
                unsigned nxt = 0u;
                if (tid == 0) nxt = __hip_atomic_fetch_add(qhead, 1u, RLX_AGENT);
                for (;;) {
                    if (tid == 0) qslot[0] = nxt;
                    __syncthreads();
                    const int uc = (int)qslot[0];
                    __syncthreads();
                    if (uc >= 1152) break;
                    if (tid == 0) nxt = __hip_atomic_fetch_add(qhead, 1u, RLX_AGENT);
                    asm volatile("" : "+v"(tid)); const int lane = tid & 63, r32 = lane & 31, hi = lane >> 5;
                    const int b = uc / 576, h = (uc / 48) % 12, x = uc % 48, gbr = x >> 4, idx = x & 15;
                    const int dil = gbr == 0 ? 1 : gbr == 1 ? 4 : 16, L = SEQ / dil;
                    const int rho = gbr == 0 ? 0 : gbr == 1 ? (idx >> 2) : idx, u0 = gbr == 0 ? idx * 256 : gbr == 1 ? (idx & 3) * 256 : 0;
                    const int jlo = (u0 == 0) ? 1 : 0, jhi = (u0 + 256 >= L) ? 4 : 5;
                    const int i_ = wid * 32 + r32;
                    TileParams tp;
                    tp.qrow = PROJ + (size_t)(b * SEQ + (u0 + i_) * dil + rho) * PITCH + C_QC + h * 128 + hi * 8;
                    const int uk0 = u0 - 64 + 64 * jlo;
                    tp.kp = PROJ + (size_t)(b * SEQ + uk0 * dil + rho) * PITCH + C_KC + h * 128;
                    tp.vp = PROJ + (size_t)(b * SEQ + uk0 * dil + rho) * PITCH + C_VC + h * 128;
                    tp.kstride = (size_t)PITCH * dil; tp.nt = jhi - jlo + 1; tp.jact_lo = (wid >> 1) - jlo; tp.jact_hi = (wid >> 1) + 2 - jlo;
                    tp.fa = (float)(i_ + 64 - 64 * jlo - 4 * hi); tp.slope = __builtin_amdgcn_exp2f((float)(h + 1) * (-8.0f / 12.0f)) * LOG2E * (float)dil; tp.tb = 0; tp.ucs = 0; tp.sh = shC;
                    f32x16 o[4]; float l_reg = 0.f;
#pragma unroll
                    for (int d = 0; d < 4; ++d) for (int r = 0; r < 16; ++r) o[d][r] = 0.f;
                    attn_tiles<2>(al, tp, o, l_reg, tid);
                    float rli[16]; row_bcast(al, wid, r32, hi, __builtin_amdgcn_rcpf(l_reg), rli);
                    bf16* cog = CO + (size_t)gbr * M * 1536;
#pragma unroll
                    for (int r = 0; r < 16; ++r) { bf16* orow = cog + (size_t)(b * SEQ + (u0 + wid * 32 + crow(r, hi)) * dil + rho) * 1536 + h * 128 + r32;
#pragma unroll
                        for (int d = 0; d < 4; ++d) orow[d * 32] = att::f2bf(o[d][r] * rli[r]); }
                    if (hi == 0) LSE[((size_t)gbr * M + b * SEQ + (u0 + i_) * dil + rho) * 12 + h] = __builtin_amdgcn_logf(l_reg);
                    __syncthreads();
#ifdef CV_FILL
                    CONVERT_FILL();
#endif
                }
            }
#ifdef CV_SUBSET
            if ((vcu % CV_SUBSET) == 0)
#endif
            while (convert_some(cvq, cv_first, cv_n, ap, ws, (LAS float*)(lds + RING_OFF + wave * 16640), tid & 63)) {}
        }
        SEAM(pb + 1);
        for (int rep_ = 0; rep_ < 1 + REP(3); ++rep_) if (EN(3) && IN(pb + 2)) { PHASE_TID(); PHASE_PTRS();
            const int hs = lane >> 4, sub = lane & 15;
            const float* go = INP(16) + (size_t)l * 128 + sub * 8;
            const f32x4 g0 = *(const GAS f32x4*)go, g1 = *(const GAS f32x4*)(go + 4);
            for (int it = gw; it < (M / 4) * 3; it += NGW) {
                const int rg = it / 3, ch = it - rg * 3, h = ch * 4 + hs;
                float ls[4][3]; v4u w[4][3];
#pragma unroll
                for (int q4 = 0; q4 < 4; ++q4)
#pragma unroll
                    for (int g = 0; g < 3; ++g) { const size_t row = (size_t)rg * 4 + q4; ls[q4][g] = LSE[((size_t)g * M + row) * 12 + h]; w[q4][g] = *(const GAS v4u*)(CO + ((size_t)g * M + row) * 1536 + h * 128 + sub * 8); }
#pragma unroll
                for (int q4 = 0; q4 < 4; ++q4) {
                    const float mx = fmaxf(ls[q4][0], fmaxf(ls[q4][1], ls[q4][2]));
                    float e[3], es = 0.f;
#pragma unroll
                    for (int g = 0; g < 3; ++g) { e[g] = __builtin_amdgcn_exp2f(ls[q4][g] - mx); es += e[g]; }
                    const float inv = __builtin_amdgcn_rcpf(es); float x[8];
#pragma unroll
                    for (int q = 0; q < 8; ++q) x[q] = 0.f;
#pragma unroll
                    for (int g = 0; g < 3; ++g) { const float wg = e[g] * inv; const unsigned ww[4] = {w[q4][g].x, w[q4][g].y, w[q4][g].z, w[q4][g].w};
#pragma unroll
                        for (int q = 0; q < 4; ++q) { x[2 * q] += wg * bflo(ww[q]); x[2 * q + 1] += wg * bfhi(ww[q]); } }
                    float s = 0.f;
#pragma unroll
                    for (int q = 0; q < 8; ++q) s += x[q] * x[q];
                    s += att::swz_xor<1>(s); s += att::swz_xor<2>(s); s += att::swz_xor<4>(s); s += att::swz_xor<8>(s);
                    const float rs = __builtin_amdgcn_rsqf(s * (1.f / 128.f) + RMS_EPS);
                    v4u o; o.x = pk2(x[0] * rs * g0.x, x[1] * rs * g0.y); o.y = pk2(x[2] * rs * g0.z, x[3] * rs * g0.w); o.z = pk2(x[4] * rs * g1.x, x[5] * rs * g1.y); o.w = pk2(x[6] * rs * g1.z, x[7] * rs * g1.w);
                    *(GAS v4u*)(MIX + ((size_t)rg * 4 + q4) * D + 2560 + h * 128 + sub * 8) = o; }
            }
        }
        SEAM(pb + 2);
        for (int rep_ = 0; rep_ < 1 + REP(4); ++rep_) if (EN(4) && IN(pb + 3)) { PHASE_TID(); PHASE_PTRS();
            pg8::Gemm g{MIX, W_OUT, M, D, D}; pg8::StaticOrder S; S.init(M, D, G, (int)blockIdx.x);
            constexpr bool xmix = (MIX_GU >> l) & 1; using ER = pg8::EpiRes<false, xmix ? GU_PITCH : 0, xmix ? GUK8 : 0>;
            ER E{X0, X1, nullptr, xmix ? ws + WS_H : nullptr, D, PSQ + (size_t)(2 * l) * M * 64, 1.0f};
            pg8::gemm_phase<ER, pg8::StaticOrder, true, true>(lds + RING_OFF, g, S, E);
        }
        SEAM(pb + 3);
        for (int rep_ = 0; rep_ < 1 + REP(5); ++rep_) if (EN(5) && IN(pb + 4)) { PHASE_TID(); PHASE_PTRS();
            constexpr int gmode = ((MIX_GU >> l) & 1) ? 2 : 0;
            pg8::Gemm g{gmode == 2 ? (const bf16*)(ws + WS_H) : X1, W_GU, M, 2 * FF, gmode == 2 ? GU_PITCH / 2 : D, gmode == 2 ? GU_T8 : 0}; pg8::StaticOrder S; S.init(M, 2 * FF, G, (int)blockIdx.x);
            const float* psrc = PSQ + (size_t)(2 * l) * M * 64;
            pg8::Unit u0; (void)S.next(0, u0); build_rstab(lds, psrc, 64, u0.pm, tid);
            if ((F8_DOWN >> l) & 1) { pg8::EpiSwiGLU<1> E{ACT, FF, FF, pg8::RowScale{(const LAS float*)(lds + RSTAB_OFF), u0.pm, psrc, 64}};
                pg8::gemm_phase<pg8::EpiSwiGLU<1>, pg8::StaticOrder, true, true, gmode>(lds + RING_OFF, g, S, E); }
            else if ((MIX_DOWN >> l) & 1) { pg8::EpiSwiGLU<2> E{ACT, MIX_PITCH, MIXK8, pg8::RowScale{(const LAS float*)(lds + RSTAB_OFF), u0.pm, psrc, 64}};
                pg8::gemm_phase<pg8::EpiSwiGLU<2>, pg8::StaticOrder, true, true, gmode>(lds + RING_OFF, g, S, E); }
            else { pg8::EpiSwiGLU<0> E{ACT, 2 * FF, 0, pg8::RowScale{(const LAS float*)(lds + RSTAB_OFF), u0.pm, psrc, 64}};
                pg8::gemm_phase<pg8::EpiSwiGLU<0>, pg8::StaticOrder, true, true, gmode>(lds + RING_OFF, g, S, E); }
        }
        SEAM(pb + 4);
        for (int rep_ = 0; rep_ < 1 + REP(6); ++rep_) if (EN(6) && IN(pb + 5)) { PHASE_TID(); PHASE_PTRS();
            constexpr int dmode = ((F8_DOWN >> l) & 1) ? 1 : ((MIX_DOWN >> l) & 1) ? 2 : 0;
            pg8::Gemm g{ACT, W_DN, M, D, dmode == 1 ? FF / 2 : dmode == 2 ? MIX_PITCH / 2 : FF, dmode == 2 ? MIX_T8 : 0}; pg8::StaticOrder S; S.init(M, D, G, (int)blockIdx.x);
            const float asc = dmode == 1 ? 1.0f / (16.0f * 64.0f) : 1.0f;
            if (l + 1 < NLAYER) { pg8::EpiRes<false> E{X1, X0, nullptr, nullptr, D, PSQ + (size_t)(2 * l + 1) * M * 64, asc};
                pg8::gemm_phase<pg8::EpiRes<false>, pg8::StaticOrder, true, true, dmode>(lds + RING_OFF, g, S, E); }
            else { pg8::EpiRes<true> E{X1, nullptr, xout, nullptr, D, nullptr, asc};
                pg8::gemm_phase<pg8::EpiRes<true>, pg8::StaticOrder, true, true, dmode>(lds + RING_OFF, g, S, E); }
        }
        SEAM(pb + 5);
    }
#undef IN
#undef SEAM
}

#ifndef MK_PER_PHASE
#define MK_PER_PHASE 0
#endif
extern "C" void kernel_launch(void* const* d_in, const int* in_sizes, int n_in, void* d_out, int out_size, void* d_ws, size_t ws_size, hipStream_t stream) {
    static int grid = 0;
    if (grid == 0) {
        if (n_in != NIN || in_sizes[0] != M * D || out_size != M * D || ws_size < WS_END) { fprintf(stderr, "kernel_launch: shape mismatch n_in %d in0 %d out %d ws %zu (need %zu)\n", n_in, n_in > 0 ? in_sizes[0] : -1, out_size, ws_size, (size_t)WS_END); grid = -1; return; }
        int dev = 0, cus = 0, per_cu = 0;
        if (hipGetDevice(&dev) != hipSuccess || hipDeviceGetAttribute(&cus, hipDeviceAttributeMultiprocessorCount, dev) != hipSuccess) { grid = -1; return; }
        if (hipFuncSetAttribute((const void*)mega_fwd, hipFuncAttributeMaxDynamicSharedMemorySize, LDS_BYTES) != hipSuccess) { fprintf(stderr, "kernel_launch: hipFuncSetAttribute failed\n"); grid = -1; return; }
        if (hipOccupancyMaxActiveBlocksPerMultiprocessor(&per_cu, (const void*)mega_fwd, NWAVES * 64, LDS_BYTES) != hipSuccess || per_cu < 1) fprintf(stderr, "kernel_launch: occupancy query reports %d\n", per_cu);
        (void)hipGetLastError();
        grid = cus;
    }
    if (grid < 0) return;
    if (hipMemsetAsync((char*)d_ws + WS_CTL, 0, CTL_ZERO_BYTES, stream) != hipSuccess) { fprintf(stderr, "kernel_launch: memset failed\n"); return; }
    Args a{};
    for (int i = 0; i < NIN; ++i) a.in[i] = (const float*)d_in[i];
    a.out = (float*)d_out; a.ws = (unsigned char*)d_ws;
#if MK_PER_PHASE
    for (int p = 0; p < NPHASE; ++p) { a.ph_lo = p; a.ph_hi = p + 1; hipLaunchKernelGGL(mega_fwd, dim3(grid), dim3(NWAVES * 64), LDS_BYTES, stream, a); }
#else
    a.ph_lo = 0; a.ph_hi = NPHASE; hipLaunchKernelGGL(mega_fwd, dim3(grid), dim3(NWAVES * 64), LDS_BYTES, stream, a);
#endif
    const hipError_t le = hipPeekAtLastError();
    if (le != hipSuccess) fprintf(stderr, "kernel_launch: launch failed: %s\n", hipGetErrorName(le));
}
```

```cpp
#define GU_T8 22
#include <hip/hip_runtime.h>
#include <cstdio>
#include <cstdint>
namespace pg8 {
#define PG8_LAS __attribute__((address_space(3)))
typedef unsigned short bf16_t;
typedef short bf16x8 __attribute__((ext_vector_type(8)));
typedef float f32x4 __attribute__((ext_vector_type(4)));
typedef unsigned u32x4 __attribute__((ext_vector_type(4)));
constexpr int BM = 256, BK = 64, HALF = 128, HTB = HALF * BK * 2  , STAGE_BYTES = 8 * HTB, NXCD = 8, WGM = 8;

__host__ __device__ __forceinline__ int lds_byte(int r, int c) { const int st = (r >> 4) * 2 + (c >> 5), rr = r & 15, cc = c & 31, ob = rr * 64 + cc * 2; return st * 1024 + (ob ^ (((ob >> 9) & 1) << 5)); }
__host__ __device__ __forceinline__ void stage_rc(int b, int& R, int& C) { const int st = b / 1024, sb = b % 1024, swz = sb ^ (((sb >> 9) & 1) << 5); R = (st >> 1) * 16 + swz / 64; C = (st & 1) * 32 + (swz % 64) / 2; }
__host__ __device__ __forceinline__ int perm32(int rho) { const int n = rho >> 4, i = rho & 15; return 8 * (i >> 2) + 4 * n + (i & 3); }

struct Unit { int pm, pn; };
struct Gemm { const bf16_t* A; const bf16_t* Bt; int M, N, K; int nt8 = 0; };

struct StaticOrder {
    int nM, nN, nwg, G, c;
    __host__ __device__ void init(int M, int N, int G_, int c_) { nM = M / BM; nN = N / BM; nwg = nM * nN; G = G_; c = c_; }
    __host__ __device__ __forceinline__ bool next(int i, Unit& u) const {
        const long L = (long)i * G + c; if (L >= nwg) return false;
        int wgid = (int)L; { const int q = nwg / NXCD, r = nwg % NXCD, xcd = wgid % NXCD, off = wgid / NXCD; wgid = (xcd < r ? xcd * (q + 1) : r * (q + 1) + (xcd - r) * q) + off; }
        const int nig = WGM * nN, gid = wgid / nig, fm = gid * WGM, gsz = (nM - fm) < WGM ? (nM - fm) : WGM;
        u.pm = fm + ((wgid % nig) % gsz); u.pn = (wgid % nig) / gsz; return true;
    }
    __device__ __forceinline__ void a_ready(const Unit&) const {}
    __device__ __forceinline__ void done(const Unit&) const {}
};

__device__ __forceinline__ unsigned cvt_pk_bf16(float lo, float hi) { unsigned r; asm volatile("v_cvt_pk_bf16_f32 %0, %1, %2" : "=v"(r) : "v"(lo), "v"(hi)); return r; }
typedef float f32x2 __attribute__((ext_vector_type(2)));
struct RowScale {
    const PG8_LAS float* rstab; int tab_pm; const float* ps; int np;
    __device__ __forceinline__ float get(int pm, int r, int row) const {
        if (pm == tab_pm) return rstab[r];
        float lo = 0.f, hi = 0.f; const int h = np > 1 ? np / 2 : 1;
        for (int i = 0; i < h; ++i) lo += ps[(size_t)row * np + i];
        if (np > 1) for (int i = 0; i < h; ++i) hi += ps[(size_t)row * np + h + i];
        return __builtin_amdgcn_rsqf((lo + hi) * (1.0f / 4096.0f) + 1e-6f);
    }
};
struct EpiProj {
    static constexpr bool PERM = true, AFTER_DRAIN = false;
    bf16_t* O; int ldc; RowScale rsc; const float *gqa, *gka, *gqb, *gkb, *gqc, *gkc; float qscale; PG8_LAS float* X;
    __device__ __forceinline__ void operator()(f32x4 (&acc)[2][2][4][2], const Unit& u, int wr, int wc, int fr, int fq) const {
        const int row0 = u.pm * BM + wr * 64 + fr, col0 = u.pn * BM + wc * 32 + 8 * fq, colt = u.pn * BM;
        const int reg = colt < 3072 ? colt / 1024 : colt < 7680 ? 3 + (colt - 3072) / 1536 : 6 + (colt - 7680) / 1536;
        const bool isv = (reg % 3) == 2, isq = (reg % 3) == 0;
#pragma unroll
        for (int ai = 0; ai < 2; ++ai)
#pragma unroll
            for (int m = 0; m < 4; ++m) { const float rs = rsc.get(u.pm, wr * 64 + fr + ai * HALF + m * 16, row0 + ai * HALF + m * 16);
#pragma unroll
                for (int bj = 0; bj < 2; ++bj) { acc[ai][bj][m][0] *= rs; acc[ai][bj][m][1] *= rs; } }
        if (!isv) {
            float sq[2][4][2];
#pragma unroll
            for (int ai = 0; ai < 2; ++ai)
#pragma unroll
                for (int m = 0; m < 4; ++m)
#pragma unroll
                    for (int bj = 0; bj < 2; ++bj) { const f32x4 a = acc[ai][bj][m][0], b = acc[ai][bj][m][1];
                        float s = (a[0] * a[0] + a[1] * a[1]) + (a[2] * a[2] + a[3] * a[3]) + (b[0] * b[0] + b[1] * b[1]) + (b[2] * b[2] + b[3] * b[3]);
                        s += __int_as_float(__builtin_amdgcn_ds_swizzle(__float_as_int(s), 0x1f | (16 << 10)));
                        auto rr = __builtin_amdgcn_permlane32_swap(__float_as_uint(s), __float_as_uint(s), false, false); sq[ai][m][bj] = __uint_as_float(rr[0]) + __uint_as_float(rr[1]); }
            if (fq == 0) {
#pragma unroll
                for (int ai = 0; ai < 2; ++ai)
#pragma unroll
                    for (int m = 0; m < 4; ++m)
#pragma unroll
                        for (int bj = 0; bj < 2; ++bj) X[(((((wr * 2 + ai) * 4 + m) * 16 + fr) * 2 + bj) * 4) + wc] = sq[ai][m][bj]; }
            asm volatile("s_waitcnt lgkmcnt(0)" ::: "memory"); __builtin_amdgcn_s_barrier(); asm volatile("" ::: "memory");
            const float* gsel = reg == 0 ? gqa : reg == 1 ? gka : reg == 3 ? gqb : reg == 4 ? gkb : reg == 6 ? gqc : gkc;
            const float* gp = gsel + wc * 32 + 8 * fq;
            const f32x4 g0 = *(const f32x4*)gp, g1 = *(const f32x4*)(gp + 4);
            const float qs = isq ? qscale : 1.0f;
#pragma unroll
            for (int ai = 0; ai < 2; ++ai)
#pragma unroll
                for (int m = 0; m < 4; ++m)
#pragma unroll
                    for (int bj = 0; bj < 2; ++bj) { const f32x4 t = *(const PG8_LAS f32x4*)(X + (((((wr * 2 + ai) * 4 + m) * 16 + fr) * 2 + bj) * 4));
                        const float r = __builtin_amdgcn_rsqf(((t[0] + t[1]) + (t[2] + t[3])) * (1.0f / 128.0f) + 1e-6f) * qs;
                        acc[ai][bj][m][0] = acc[ai][bj][m][0] * r * g0; acc[ai][bj][m][1] = acc[ai][bj][m][1] * r * g1; }
        }
#pragma unroll
        for (int ai = 0; ai < 2; ++ai)
#pragma unroll
            for (int m = 0; m < 4; ++m) { bf16_t* rowp = O + (size_t)(row0 + ai * HALF + m * 16) * ldc + col0;
#pragma unroll
                for (int bj = 0; bj < 2; ++bj) { const f32x4 v0 = acc[ai][bj][m][0], v1 = acc[ai][bj][m][1];
                    u32x4 w; w.x = cvt_pk_bf16(v0[0], v0[1]); w.y = cvt_pk_bf16(v0[2], v0[3]); w.z = cvt_pk_bf16(v1[0], v1[1]); w.w = cvt_pk_bf16(v1[2], v1[3]);
                    *(u32x4*)(rowp + bj * HALF) = w; } }
    }
};
__device__ __forceinline__ float silu_mul(float g, float u) { return g * __builtin_amdgcn_rcpf(1.0f + __builtin_amdgcn_exp2f(g * -1.4426950408889634f)) * u; }
template <int F8OUT> struct EpiSwiGLU {
    static constexpr bool PERM = true, AFTER_DRAIN = false;
    bf16_t* O; int ldb, k8; RowScale rsc;
    __device__ __forceinline__ void operator()(const f32x4 (&acc)[2][2][4][2], const Unit& u, int wr, int wc, int fr, int fq) const {
        const int row0 = u.pm * BM + wr * 64 + fr, col0 = u.pn * HALF + wc * 32 + 8 * fq;
        const bool f8 = F8OUT == 1 || (F8OUT == 2 && u.pn * HALF < k8);
#pragma unroll
        for (int ai = 0; ai < 2; ++ai)
#pragma unroll
            for (int m = 0; m < 4; ++m) { unsigned char* rp = (unsigned char*)O + (size_t)(row0 + ai * HALF + m * 16) * ldb;
                const float rs = rsc.get(u.pm, wr * 64 + fr + ai * HALF + m * 16, row0 + ai * HALF + m * 16);
                const f32x4 g0 = acc[ai][0][m][0] * rs, g1 = acc[ai][0][m][1] * rs, u0 = acc[ai][1][m][0] * rs, u1 = acc[ai][1][m][1] * rs;
                const float s0 = silu_mul(g0[0], u0[0]), s1 = silu_mul(g0[1], u0[1]), s2 = silu_mul(g0[2], u0[2]), s3 = silu_mul(g0[3], u0[3]);
                const float s4 = silu_mul(g1[0], u1[0]), s5 = silu_mul(g1[1], u1[1]), s6 = silu_mul(g1[2], u1[2]), s7 = silu_mul(g1[3], u1[3]);
                if (f8) {
                    unsigned w0 = 0u, w1 = 0u;
#define F8V(x) __builtin_amdgcn_fmed3f(16.f * (x), -448.f, 448.f)
                    w0 = __builtin_amdgcn_cvt_pk_fp8_f32(F8V(s0), F8V(s1), w0, false); w0 = __builtin_amdgcn_cvt_pk_fp8_f32(F8V(s2), F8V(s3), w0, true);
                    w1 = __builtin_amdgcn_cvt_pk_fp8_f32(F8V(s4), F8V(s5), w1, false); w1 = __builtin_amdgcn_cvt_pk_fp8_f32(F8V(s6), F8V(s7), w1, true);
#undef F8V
                    typedef unsigned u32x2_ __attribute__((ext_vector_type(2))); *(u32x2_*)(rp + col0) = (u32x2_){w0, w1};
                } else {
                    u32x4 w; w.x = cvt_pk_bf16(s0, s1); w.y = cvt_pk_bf16(s2, s3); w.z = cvt_pk_bf16(s4, s5); w.w = cvt_pk_bf16(s6, s7);
                    *(u32x4*)(rp + k8 + (col0 - k8) * 2) = w; } }
    }
};
__device__ __forceinline__ float bf_lo(unsigned w) { return __uint_as_float(w << 16); }
__device__ __forceinline__ float bf_hi(unsigned w) { return __uint_as_float(w & 0xffff0000u); }
template <bool FINAL, int XMP = 0, int XK8 = 0> struct EpiRes {
    static constexpr bool PERM = true, AFTER_DRAIN = false;
    const bf16_t* base; bf16_t* out; float* outf;
    unsigned char* xm;
    int ldc; float* ps; float ascale;
    __device__ __forceinline__ void operator()(const f32x4 (&acc)[2][2][4][2], const Unit& u, int wr, int wc, int fr, int fq) const {
        int frl = fr, fql = fq; asm volatile("" : "+v"(frl), "+v"(fql));
        const int row0 = u.pm * BM + wr * 64 + frl, col0 = u.pn * BM + wc * 32 + 8 * fql;
        u32x4 bv[2][4][2];
#pragma unroll
        for (int ai = 0; ai < 2; ++ai)
#pragma unroll
            for (int m = 0; m < 4; ++m)
#pragma unroll
                for (int bj = 0; bj < 2; ++bj) bv[ai][m][bj] = *(const u32x4*)(base + (size_t)(row0 + ai * HALF + m * 16) * ldc + col0 + bj * HALF);
#pragma unroll
        for (int ai = 0; ai < 2; ++ai)
#pragma unroll
            for (int m = 0; m < 4; ++m) { const int row = row0 + ai * HALF + m * 16; const size_t off = (size_t)row * ldc + col0; float sp = 0.f;
#pragma unroll
                for (int bj = 0; bj < 2; ++bj) { const u32x4 b = bv[ai][m][bj];
                    const f32x4 v0 = (f32x4){bf_lo(b.x), bf_hi(b.x), bf_lo(b.y), bf_hi(b.y)} + acc[ai][bj][m][0] * ascale, v1 = (f32x4){bf_lo(b.z), bf_hi(b.z), bf_lo(b.w), bf_hi(b.w)} + acc[ai][bj][m][1] * ascale;
                    if constexpr (FINAL) { *(f32x4*)(outf + off + bj * HALF) = v0; *(f32x4*)(outf + off + bj * HALF + 4) = v1; }
                    else { sp += (v0[0] * v0[0] + v0[1] * v0[1]) + (v0[2] * v0[2] + v0[3] * v0[3]) + (v1[0] * v1[0] + v1[1] * v1[1]) + (v1[2] * v1[2] + v1[3] * v1[3]);
                        u32x4 w; w.x = cvt_pk_bf16(v0[0], v0[1]); w.y = cvt_pk_bf16(v0[2], v0[3]); w.z = cvt_pk_bf16(v1[0], v1[1]); w.w = cvt_pk_bf16(v1[2], v1[3]);
                        *(u32x4*)(out + off + bj * HALF) = w;
                        if constexpr (XMP > 0) { unsigned char* xr = xm + (size_t)row * XMP; const int c = col0 + bj * HALF;
                            if (u.pn * BM < XK8) { unsigned w0 = 0u, w1 = 0u;
#define F8V(x) __builtin_amdgcn_fmed3f(16.f * (x), -448.f, 448.f)
                                w0 = __builtin_amdgcn_cvt_pk_fp8_f32(F8V(v0[0]), F8V(v0[1]), w0, false); w0 = __builtin_amdgcn_cvt_pk_fp8_f32(F8V(v0[2]), F8V(v0[3]), w0, true);
                                w1 = __builtin_amdgcn_cvt_pk_fp8_f32(F8V(v1[0]), F8V(v1[1]), w1, false); w1 = __builtin_amdgcn_cvt_pk_fp8_f32(F8V(v1[2]), F8V(v1[3]), w1, true);
#undef F8V
                                typedef unsigned u32x2_ __attribute__((ext_vector_type(2))); *(u32x2_*)(xr + c) = (u32x2_){w0, w1}; }
                            else *(u32x4*)(xr + XK8 + (c - XK8) * 2) = w; } } }
                if constexpr (!FINAL) { sp += __int_as_float(__builtin_amdgcn_ds_swizzle(__float_as_int(sp), 0x1f | (16 << 10)));
                    auto rr = __builtin_amdgcn_permlane32_swap(__float_as_uint(sp), __float_as_uint(sp), false, false); sp = __uint_as_float(rr[0]) + __uint_as_float(rr[1]);
                    if (fql == 0) ps[(size_t)row * 64 + u.pn * 4 + wc] = sp; } }
    }
};
typedef int pg8_i32x8 __attribute__((ext_vector_type(8))); typedef int pg8_i32x4 __attribute__((ext_vector_type(4)));
__device__ __forceinline__ pg8_i32x8 pg8_cat(bf16x8 a, bf16x8 b) { const pg8_i32x4 x = __builtin_bit_cast(pg8_i32x4, a), y = __builtin_bit_cast(pg8_i32x4, b); return __builtin_shufflevector(x, y, 0, 1, 2, 3, 4, 5, 6, 7); }
template <class Epi, class Sched, bool ALIGN_EPI = false, bool SP2 = false, int FP8 = 0>
__device__ __forceinline__ void gemm_phase(PG8_LAS unsigned char* lds, const Gemm g, const Sched& S, const Epi& E) {
    int tid_ = threadIdx.x; asm volatile("" : "+v"(tid_));
    const int tid = tid_, wid = __builtin_amdgcn_readfirstlane(tid >> 6), lane = tid & 63, wr = wid >> 2, wc = wid & 3, fr = lane & 15, fq = lane >> 4;
    const int K = g.K, nt = K / BK;
    unsigned voffA[2], voffB[2];
#pragma unroll
    for (int i = 0; i < 2; ++i) { int R, C; stage_rc(tid * 16 + i * 8192, R, C); const int Rb = Epi::PERM ? ((R & ~31) + perm32(R & 31)) : R;
        voffA[i] = (unsigned)(R * K + C) * 2u; voffB[i] = (unsigned)(Rb * K + C) * 2u; }
    const size_t kstep = (size_t)(BK * 2);
    const size_t hstep = (size_t)HALF * K * 2;
    const size_t tstep = 2 * hstep;
    const unsigned ldsw = (unsigned)wid * 1024u;
    const int aoff = lds_byte(wr * 64 + fr, fq * 8), boff = lds_byte(wc * 32 + fr, fq * 8);
#define PG8_SA(b, h) (((b) * 2 + (h)) * HTB)
#define PG8_SB(b, h) ((4 + (b) * 2 + (h)) * HTB)
#define PG8_STAGE(bufoff, gbase, voff) do { _Pragma("unroll") for (int _i = 0; _i < 2; ++_i) \
        __builtin_amdgcn_global_load_lds((const unsigned*)((const char*)(gbase) + (voff)[_i]), (PG8_LAS unsigned*)(lds + (bufoff) + ldsw + _i * 8192), 16, 0, 0); } while (0)
#define PG8_LDA(dst, b, h) do { if constexpr (FP8_) { _Pragma("unroll") for (int m = 0; m < 4; ++m) { const pg8_i32x4 lo_ = *(const PG8_LAS pg8_i32x4*)(lds + PG8_SA(b, h) + aoff + m * 2048), hi_ = *(const PG8_LAS pg8_i32x4*)(lds + PG8_SA(b, h) + aoff + m * 2048 + 1024); dst##8[m] = __builtin_shufflevector(lo_, hi_, 0, 1, 2, 3, 4, 5, 6, 7); } } \
        else { _Pragma("unroll") for (int m = 0; m < 4; ++m) _Pragma("unroll") for (int k = 0; k < 2; ++k) dst[m][k] = *(const PG8_LAS bf16x8*)(lds + PG8_SA(b, h) + aoff + m * 2048 + k * 1024); } } while (0)
#define PG8_LDB(dst, b, h) do { if constexpr (FP8_) { _Pragma("unroll") for (int n = 0; n < 2; ++n) { const pg8_i32x4 lo_ = *(const PG8_LAS pg8_i32x4*)(lds + PG8_SB(b, h) + boff + n * 2048), hi_ = *(const PG8_LAS pg8_i32x4*)(lds + PG8_SB(b, h) + boff + n * 2048 + 1024); dst##8[n] = __builtin_shufflevector(lo_, hi_, 0, 1, 2, 3, 4, 5, 6, 7); } } \
        else { _Pragma("unroll") for (int n = 0; n < 2; ++n) _Pragma("unroll") for (int k = 0; k < 2; ++k) dst[n][k] = *(const PG8_LAS bf16x8*)(lds + PG8_SB(b, h) + boff + n * 2048 + k * 1024); } } while (0)
#define PG8_MMA(ai, bj, At, Bt) do { __builtin_amdgcn_s_setprio(1); \
        if constexpr (FP8_) { _Pragma("unroll") for (int m = 0; m < 4; ++m) { \
            f32x4 c0_ = __builtin_shufflevector(acc8[ai][bj][m], acc8[ai][bj][m], 0, 1, 2, 3), c1_ = __builtin_shufflevector(acc8[ai][bj][m], acc8[ai][bj][m], 4, 5, 6, 7); \
            asm volatile("v_mfma_scale_f32_16x16x128_f8f6f4 %0, %1, %2, %0, %3, %3 op_sel_hi:[0,0,0]" : "+v"(c0_) : "v"(Bt##8[0]), "v"(At##8[m]), "v"(sc127_));   \
            asm volatile("v_mfma_scale_f32_16x16x128_f8f6f4 %0, %1, %2, %0, %3, %3 op_sel_hi:[0,0,0]" : "+v"(c1_) : "v"(Bt##8[1]), "v"(At##8[m]), "v"(sc127_)); \
            acc8[ai][bj][m] = __builtin_shufflevector(c0_, c1_, 0, 1, 2, 3, 4, 5, 6, 7); } } \
        else { _Pragma("unroll") for (int m = 0; m < 4; ++m) _Pragma("unroll") for (int n = 0; n < 2; ++n) _Pragma("unroll") for (int k = 0; k < 2; ++k) \
            acc[ai][bj][m][n] = __builtin_amdgcn_mfma_f32_16x16x32_bf16(Bt[n][k], At[m][k], acc[ai][bj][m][n], 0, 0, 0); } \
        __builtin_amdgcn_s_setprio(0); } while (0)
#define PG8_WAIT_V(n) asm volatile("s_waitcnt vmcnt(" #n ")" ::: "memory")
#define PG8_WAIT_L(n) asm volatile("s_waitcnt lgkmcnt(" #n ")" ::: "memory")
#define PG8_BAR __builtin_amdgcn_s_barrier()
#define PG8_SCHED __builtin_amdgcn_sched_barrier(0)
#define PG8_KLOOP(F8, T0, T1) do { \
        for (int t = (T0); t < (T1); t += 2) { constexpr bool FP8_ = (F8); \
            const bool last = (t == nt - 2); \
            const char* a1 = cA + (size_t)(t + 1) * kstep; \
            const char* a2 = last ? nA : cA + (size_t)(t + 2) * kstep; const char* b2 = last ? nB : cB + (size_t)(t + 2) * kstep; \
            const char* a3 = a2 + kstep; const char* b3 = b2 + kstep; \
            if (last && has_next) S.a_ready(nxt); \
            PG8_LDB(B0, 0, 0); PG8_LDB(B1, 0, 1); PG8_SCHED; PG8_LDA(At, 0, 0); PG8_STAGE(PG8_SA(1, 1), a1 + hstep, voffA); \
            PG8_WAIT_V(8); PG8_WAIT_L(0); PG8_BAR; PG8_MMA(0, 0, At, B0); PG8_MMA(0, 1, At, B1); PG8_BAR; PG8_SCHED; \
            PG8_LDA(At, 0, 1); PG8_STAGE(PG8_SB(0, 0), b2, voffB); PG8_STAGE(PG8_SB(0, 1), b2 + hstep, voffB); PG8_STAGE(PG8_SA(0, 0), a2, voffA); \
            PG8_WAIT_V(8); PG8_WAIT_L(0); PG8_BAR; PG8_MMA(1, 0, At, B0); PG8_MMA(1, 1, At, B1); PG8_BAR; PG8_SCHED; \
            PG8_LDB(B0, 1, 0); PG8_LDB(B1, 1, 1); PG8_SCHED; PG8_LDA(At, 1, 0); PG8_STAGE(PG8_SA(0, 1), a2 + hstep, voffA); \
            PG8_WAIT_V(8); PG8_WAIT_L(0); PG8_BAR; PG8_MMA(0, 0, At, B0); PG8_MMA(0, 1, At, B1); PG8_BAR; PG8_SCHED; \
            PG8_LDA(At, 1, 1); PG8_STAGE(PG8_SB(1, 0), b3, voffB); PG8_STAGE(PG8_SB(1, 1), b3 + hstep, voffB); PG8_STAGE(PG8_SA(1, 0), a3, voffA); \
            PG8_WAIT_V(8); PG8_WAIT_L(0); PG8_BAR; PG8_MMA(1, 0, At, B0); PG8_MMA(1, 1, At, B1); PG8_BAR; PG8_SCHED; \
        } \
    } while (0)
    Unit cur, nxt; int ui = 0;
    if (!S.next(0, cur)) return;
    f32x4 acc[2][2][4][2];
    typedef float pg8_f32x8 __attribute__((ext_vector_type(8)));
    const int sc127_ = 127;
    pg8_f32x8 acc8[2][2][4];
#pragma unroll
    for (int a = 0; a < 2; ++a)
#pragma unroll
        for (int b = 0; b < 2; ++b)
#pragma unroll
            for (int m = 0; m < 4; ++m) acc8[a][b][m] = (pg8_f32x8){0.f, 0.f, 0.f, 0.f, 0.f, 0.f, 0.f, 0.f};
#pragma unroll
    for (int a = 0; a < 2; ++a)
#pragma unroll
        for (int b = 0; b < 2; ++b)
#pragma unroll
            for (int m = 0; m < 4; ++m)
#pragma unroll
                for (int n = 0; n < 2; ++n) acc[a][b][m][n] = (f32x4){0.f, 0.f, 0.f, 0.f};
    bf16x8 At[4][2], B0[2][2], B1[2][2]; pg8_i32x8 At8[4], B08[2], B18[2];
    const char* cA = (const char*)g.A + (size_t)cur.pm * tstep; const char* cB = (const char*)g.Bt + (size_t)cur.pn * tstep;
    S.a_ready(cur);
    if constexpr (SP2) {
        PG8_STAGE(PG8_SB(0, 0), cB, voffB); PG8_STAGE(PG8_SB(0, 1), cB + hstep, voffB); PG8_STAGE(PG8_SA(0, 0), cA, voffA); PG8_STAGE(PG8_SA(0, 1), cA + hstep, voffA);
        if (wr == 1) PG8_BAR;
        PG8_WAIT_V(2); PG8_BAR;
        PG8_STAGE(PG8_SB(1, 0), cB + kstep, voffB); PG8_STAGE(PG8_SA(1, 0), cA + kstep, voffA); PG8_STAGE(PG8_SB(1, 1), cB + hstep + kstep, voffB);
        PG8_WAIT_V(6); PG8_BAR;
    } else {
        PG8_STAGE(PG8_SB(0, 0), cB, voffB); PG8_STAGE(PG8_SA(0, 0), cA, voffA); PG8_STAGE(PG8_SB(0, 1), cB + hstep, voffB); PG8_STAGE(PG8_SA(0, 1), cA + hstep, voffA);
        if (wr == 1) PG8_BAR;
        PG8_WAIT_V(4); PG8_BAR;
        PG8_STAGE(PG8_SB(1, 0), cB + kstep, voffB); PG8_STAGE(PG8_SA(1, 0), cA + kstep, voffA); PG8_STAGE(PG8_SB(1, 1), cB + hstep + kstep, voffB);
        PG8_WAIT_V(6); PG8_BAR;
    }
    for (;;) {
        const bool has_next = S.next(ui + 1, nxt);
        const char* nA = has_next ? (const char*)g.A + (size_t)nxt.pm * tstep : cA; const char* nB = has_next ? (const char*)g.Bt + (size_t)nxt.pn * tstep : cB;
        static_assert(SP2, "the K-loop is the two-super-phase form");
        if constexpr (FP8 == 2) {
            PG8_KLOOP(true, 0, g.nt8);
#pragma unroll
            for (int a = 0; a < 2; ++a)
#pragma unroll
                for (int b = 0; b < 2; ++b)
#pragma unroll
                    for (int m = 0; m < 4; ++m) { acc[a][b][m][0] = __builtin_shufflevector(acc8[a][b][m], acc8[a][b][m], 0, 1, 2, 3) * (1.0f / 1024.0f); acc[a][b][m][1] = __builtin_shufflevector(acc8[a][b][m], acc8[a][b][m], 4, 5, 6, 7) * (1.0f / 1024.0f); }
            PG8_KLOOP(false, g.nt8, nt);
        } else if constexpr (FP8 == 1) { PG8_KLOOP(true, 0, nt); }
        else { PG8_KLOOP(false, 0, nt); }
        if constexpr (ALIGN_EPI) { if (wr == 0) PG8_BAR; }
        if constexpr (FP8 == 1) {
#pragma unroll
            for (int a = 0; a < 2; ++a)
#pragma unroll
                for (int b = 0; b < 2; ++b)
#pragma unroll
                    for (int m = 0; m < 4; ++m) { acc[a][b][m][0] = __builtin_shufflevector(acc8[a][b][m], acc8[a][b][m], 0, 1, 2, 3); acc[a][b][m][1] = __builtin_shufflevector(acc8[a][b][m], acc8[a][b][m], 4, 5, 6, 7); } }
        if constexpr (!Epi::AFTER_DRAIN) { E(acc, cur, wr, wc, fr, fq); S.done(cur); }
        if (!has_next) break;
#pragma unroll
        for (int a = 0; a < 2; ++a)
#pragma unroll
            for (int b = 0; b < 2; ++b)
#pragma unroll
                for (int m = 0; m < 4; ++m)
#pragma unroll
                    for (int n = 0; n < 2; ++n) acc[a][b][m][n] = (f32x4){0.f, 0.f, 0.f, 0.f};
        if constexpr (FP8 != 0) {
#pragma unroll
            for (int a = 0; a < 2; ++a)
#pragma unroll
                for (int b = 0; b < 2; ++b)
#pragma unroll
                    for (int m = 0; m < 4; ++m) acc8[a][b][m] = (pg8_f32x8){0.f, 0.f, 0.f, 0.f, 0.f, 0.f, 0.f, 0.f}; }
        cur = nxt; cA = nA; cB = nB; ++ui;
        if constexpr (ALIGN_EPI) { if (wr == 1) PG8_BAR; }
    }
    PG8_WAIT_V(0);
    if constexpr (!ALIGN_EPI) { if (wr == 0) PG8_BAR; }
    PG8_BAR;
    if constexpr (Epi::AFTER_DRAIN) { E.fused(acc, cur, wr, wc, fr, fq, lds, wid, lane); S.done(cur); }
#undef PG8_SA
#undef PG8_SB
#undef PG8_STAGE
#undef PG8_LDA
#undef PG8_LDB
#undef PG8_MMA
#undef PG8_WAIT_V
#undef PG8_WAIT_L
#undef PG8_BAR
#undef PG8_SCHED
#undef PG8_KLOOP
}
}
namespace att {
#define ALAS __attribute__((address_space(3)))
typedef unsigned short bf16;
typedef short bf16x8 __attribute__((ext_vector_type(8)));
typedef short s16x4 __attribute__((ext_vector_type(4)));
typedef float f32x16 __attribute__((ext_vector_type(16)));
typedef float f32x4 __attribute__((ext_vector_type(4)));
typedef unsigned u32x4 __attribute__((ext_vector_type(4)));
constexpr int PITCH = 12288;
constexpr int DM = 4096;
constexpr int OFF_K = 0, OFF_V = 32768, OFF_P = 98304;
constexpr int GK = 0, GV = 65536, OFF_TAB = 131072;
constexpr int OFF_WS = 138752, OFF_SSX = OFF_WS + 2048, ATT_LDS = OFF_SSX + 1024;
constexpr float LOG2E = 1.4426950408889634f;

#define KSWZ(row, colB) ((row) * 256 + ((colB) ^ (((row) & 7) << 4)))
#define ASBAR() __builtin_amdgcn_sched_barrier(0)
__device__ __forceinline__ constexpr int crow0(int r) { return (r & 3) + 8 * (r >> 2); }
__device__ __forceinline__ int crow(int r, int hi) { return (r & 3) + 8 * (r >> 2) + 4 * hi; }
__device__ __forceinline__ unsigned cvtpk(float lo, float hi) { unsigned r; asm volatile("v_cvt_pk_bf16_f32 %0, %1, %2" : "=v"(r) : "v"(lo), "v"(hi)); return r; }
__device__ __forceinline__ float bf2f(unsigned short b) { return __uint_as_float(((unsigned)b) << 16); }
__device__ __forceinline__ unsigned short f2bf(float f) { return (unsigned short)(cvtpk(f, f) & 0xffffu); }
__device__ __forceinline__ int v_st(int k, int c) { const int kk = (k & ~0xC) | ((k & 4) << 1) | ((k & 8) >> 1); return ((kk >> 3) * 4 + (c >> 5)) * 512 + ((kk & 7) * 32 + (c & 31)) * 2; }
__device__ __forceinline__ int v_rd_base(int lane) { return ((lane & 3) << 3) | (((lane >> 2) & 3) << 6) | (((lane >> 4) & 1) << 5) | (((lane >> 5) & 1) << 8); }
constexpr int v_rd_off(int d0, int ks, int half) { return d0 * 512 + ks * 4096 + half * 2048; }
template <int OFF> __device__ __forceinline__ s16x4 tr_read(int vb) { s16x4 r; asm volatile("ds_read_b64_tr_b16 %0, %1 offset:%2" : "=&v"(r) : "v"(vb), "i"(OFF) : "memory"); return r; }
struct VFragK { s16x4 l[4], h[4]; };
template <int KS> __device__ __forceinline__ void v_readk(VFragK& f, int vb) {
  f.l[0] = tr_read<v_rd_off(0, KS, 0)>(vb); f.h[0] = tr_read<v_rd_off(0, KS, 1)>(vb); f.l[1] = tr_read<v_rd_off(1, KS, 0)>(vb); f.h[1] = tr_read<v_rd_off(1, KS, 1)>(vb);
  f.l[2] = tr_read<v_rd_off(2, KS, 0)>(vb); f.h[2] = tr_read<v_rd_off(2, KS, 1)>(vb); f.l[3] = tr_read<v_rd_off(3, KS, 0)>(vb); f.h[3] = tr_read<v_rd_off(3, KS, 1)>(vb);
}
#define APK(L, H) (bf16x8){L[0], L[1], L[2], L[3], H[0], H[1], H[2], H[3]}
__device__ __forceinline__ void pv_d0(f32x16 (&o)[4], int vb, bf16x8 pa0, bf16x8 pa1, bf16x8 pa2, bf16x8 pa3) {
  VFragK A, B;
  v_readk<0>(A, vb);
  v_readk<1>(B, vb); asm volatile("s_waitcnt lgkmcnt(8)" ::: "memory"); ASBAR();
#pragma unroll
  for (int d = 0; d < 4; ++d) o[d] = __builtin_amdgcn_mfma_f32_32x32x16_bf16(pa0, APK(A.l[d], A.h[d]), o[d], 0, 0, 0);
  ASBAR(); v_readk<2>(A, vb); asm volatile("s_waitcnt lgkmcnt(8)" ::: "memory"); ASBAR();
#pragma unroll
  for (int d = 0; d < 4; ++d) o[d] = __builtin_amdgcn_mfma_f32_32x32x16_bf16(pa1, APK(B.l[d], B.h[d]), o[d], 0, 0, 0);
  ASBAR(); v_readk<3>(B, vb); asm volatile("s_waitcnt lgkmcnt(8)" ::: "memory"); ASBAR();
#pragma unroll
  for (int d = 0; d < 4; ++d) o[d] = __builtin_amdgcn_mfma_f32_32x32x16_bf16(pa2, APK(A.l[d], A.h[d]), o[d], 0, 0, 0);
  ASBAR(); asm volatile("s_waitcnt lgkmcnt(0)" ::: "memory"); ASBAR();
#pragma unroll
  for (int d = 0; d < 4; ++d) o[d] = __builtin_amdgcn_mfma_f32_32x32x16_bf16(pa3, APK(B.l[d], B.h[d]), o[d], 0, 0, 0);
  ASBAR();
}
__device__ __forceinline__ void qkt(f32x16& p0, f32x16& p1, const ALAS char* Ks, const bf16x8 (&qr)[8], int r32, int hi) {
  for (int r = 0; r < 16; ++r) { p0[r] = 0.f; p1[r] = 0.f; }
  bf16x8 k0[8], k1[8];
#pragma unroll
  for (int d0 = 0; d0 < 8; ++d0) { k0[d0] = *(const ALAS bf16x8*)(Ks + KSWZ(r32, (d0 * 16 + hi * 8) * 2)); k1[d0] = *(const ALAS bf16x8*)(Ks + KSWZ(32 + r32, (d0 * 16 + hi * 8) * 2)); }
  asm volatile("s_waitcnt lgkmcnt(8)" ::: "memory"); ASBAR();
#pragma unroll
  for (int d0 = 0; d0 < 4; ++d0) { p0 = __builtin_amdgcn_mfma_f32_32x32x16_bf16(k0[d0], qr[d0], p0, 0, 0, 0); p1 = __builtin_amdgcn_mfma_f32_32x32x16_bf16(k1[d0], qr[d0], p1, 0, 0, 0); }
  asm volatile("s_waitcnt lgkmcnt(0)" ::: "memory"); ASBAR();
#pragma unroll
  for (int d0 = 4; d0 < 8; ++d0) { p0 = __builtin_amdgcn_mfma_f32_32x32x16_bf16(k0[d0], qr[d0], p0, 0, 0, 0); p1 = __builtin_amdgcn_mfma_f32_32x32x16_bf16(k1[d0], qr[d0], p1, 0, 0, 0); }
}
struct TileParams {
  const bf16* qrow;
  const bf16* kp;
  const bf16* vp;
  size_t kstride;
  int nt;
  int jact_lo, jact_hi;
  float fa;
  float slope;
  int tb;
  int ucs;
  float sh;
};
template <int MODE>
__device__ __forceinline__ void attn_tiles(ALAS char* lds, const TileParams& tp, f32x16 (&o)[4], float& l_reg, int tid) {
  const int wid = __builtin_amdgcn_readfirstlane(tid >> 6), lane = tid & 63, r32 = lane & 31, hi = lane >> 5;
  const ALAS float* tab = (const ALAS float*)(lds + OFF_TAB);
  bf16x8 qr[8];
#pragma unroll
  for (int d0 = 0; d0 < 8; ++d0) qr[d0] = *(const bf16x8*)(tp.qrow + d0 * 16);
  const int vb0 = (int)(unsigned)(uintptr_t)(lds + GV) + v_rd_base(lane);
  unsigned koff[2], voff[2];
#pragma unroll
  for (int i = 0; i < 2; ++i) { const int q = 2 * wid + i;
    const int krow = 4 * q + (lane >> 4), kcolB = ((lane & 15) << 4) ^ ((krow & 7) << 4);
    koff[i] = (unsigned)krow * (unsigned)(tp.kstride * 2) + (unsigned)kcolB;
    const int sub = 2 * q + (lane >> 5), kk = (sub >> 2) * 8 + ((lane & 31) >> 2), c = (sub & 3) * 32 + (lane & 3) * 8, k = (kk & ~0xC) | ((kk & 4) << 1) | ((kk & 8) >> 1);
    voff[i] = (unsigned)k * (unsigned)(tp.kstride * 2) + (unsigned)(c * 2); }
#define DMA(j) do { const int sl_ = (((j) >> 1) & 1) * 2 + ((j) & 1); const char* kb_ = (const char*)tp.kp + (size_t)(j) * 128 * tp.kstride; const char* vb_ = (const char*)tp.vp + (size_t)(j) * 128 * tp.kstride; \
    _Pragma("unroll") for (int i_ = 0; i_ < 2; ++i_) __builtin_amdgcn_global_load_lds((const unsigned*)(kb_ + koff[i_]), (ALAS unsigned*)(lds + GK + sl_ * 16384 + (2 * wid + i_) * 1024), 16, 0, 0); \
    _Pragma("unroll") for (int i_ = 0; i_ < 2; ++i_) __builtin_amdgcn_global_load_lds((const unsigned*)(vb_ + voff[i_]), (ALAS unsigned*)(lds + GV + sl_ * 16384 + (2 * wid + i_) * 1024), 16, 0, 0); } while (0)
  DMA(0); if (tp.nt > 1) DMA(1);
  for (int j0 = 0; j0 < tp.nt; j0 += 2) {
    asm volatile("s_waitcnt vmcnt(0)" ::: "memory"); __syncthreads();
    if (j0 + 2 < tp.nt) DMA(j0 + 2);
    if (j0 + 3 < tp.nt) DMA(j0 + 3);
#pragma unroll 1
    for (int j = j0; j < j0 + 2; ++j) {
    const int b = ((j >> 1) & 1) * 2 + (j & 1);
    const bool act = (j < tp.nt) && (j >= tp.jact_lo && j <= tp.jact_hi);
    if (act) {
      f32x16 p0, p1;
      qkt(p0, p1, lds + GK + b * 16384, qr, r32, hi);
      if constexpr (MODE == 2) {
        const float a = tp.fa - (float)(64 * j);
#pragma unroll
        for (int r = 0; r < 16; ++r) { const float d0 = fabsf(a - (float)crow0(r)), d1 = fabsf(a - (float)(32 + crow0(r)));
          p0[r] = d0 <= 64.f ? fmaf(-tp.slope, d0, p0[r]) : -INFINITY; p1[r] = d1 <= 64.f ? fmaf(-tp.slope, d1, p1[r]) : -INFINITY; }
        if (tp.sh != 0.f) {
#pragma unroll
          for (int r = 0; r < 16; ++r) { p0[r] -= tp.sh; p1[r] -= tp.sh; } }
      } else {
        const int tbj = tp.tb + 128 * j;
#pragma unroll
        for (int r = 0; r < 16; ++r) { const float b0 = tab[tbj + crow0(r)], b1 = tab[tbj + 32 + crow0(r)];
          p0[r] = (unsigned)(tp.ucs + crow0(r)) < 16u ? p0[r] + b0 : -INFINITY; p1[r] = (unsigned)(tp.ucs + 32 + crow0(r)) < 16u ? p1[r] + b1 : -INFINITY; }
      }
#pragma unroll
      for (int r = 0; r < 16; ++r) { p0[r] = __builtin_amdgcn_exp2f(p0[r]); p1[r] = __builtin_amdgcn_exp2f(p1[r]); }
      float ps = 0.f;
#pragma unroll
      for (int r = 0; r < 16; ++r) ps += p0[r] + p1[r];
      { auto rr = __builtin_amdgcn_permlane32_swap(__float_as_uint(ps), __float_as_uint(ps), false, false); ps = __uint_as_float(rr[0]) + __uint_as_float(rr[1]); }
      l_reg += ps;
      bf16x8 pa0, pa1, pa2, pa3;
#define PK4(P, BASE, OUT) do { unsigned a0 = cvtpk(P[BASE + 0], P[BASE + 1]), a1 = cvtpk(P[BASE + 2], P[BASE + 3]);   \
    unsigned b0_ = cvtpk(P[BASE + 4], P[BASE + 5]), b1_ = cvtpk(P[BASE + 6], P[BASE + 7]);                              \
    auto r0 = __builtin_amdgcn_permlane32_swap(a0, b0_, false, false); auto r1 = __builtin_amdgcn_permlane32_swap(a1, b1_, false, false); \
    u32x4 w = {r0[0], r1[0], r0[1], r1[1]}; OUT = *reinterpret_cast<bf16x8*>(&w); } while (0)
      PK4(p0, 0, pa0); PK4(p0, 8, pa1); PK4(p1, 0, pa2); PK4(p1, 8, pa3);
      pv_d0(o, vb0 + b * 16384, pa0, pa1, pa2, pa3);
    }
    }
  }
#undef DMA
}
__device__ __forceinline__ void attn_tiles_A(ALAS char* lds, const TileParams& tp, f32x16 (&o)[4], float& l_reg, int tid) {
  const int wid = __builtin_amdgcn_readfirstlane(tid >> 6), lane = tid & 63, r32 = lane & 31, hi = lane >> 5, kh = wid >> 2;
  bf16x8 qr[8];
#pragma unroll
  for (int d0 = 0; d0 < 8; ++d0) qr[d0] = *(const bf16x8*)(tp.qrow + d0 * 16);
  const int vb0 = (int)(unsigned)(uintptr_t)(lds + OFF_V) + kh * 16384 + v_rd_base(lane);
  unsigned koff[2], voff[2];
#pragma unroll
  for (int i = 0; i < 2; ++i) { const int q = 2 * wid + i;
    const int krow = 4 * q + (lane >> 4), kcolB = ((lane & 15) << 4) ^ ((krow & 7) << 4);
    koff[i] = (unsigned)krow * (unsigned)(tp.kstride * 2) + (unsigned)kcolB;
    const int sub = 2 * q + (lane >> 5), kk = (sub >> 2) * 8 + ((lane & 31) >> 2), c = (sub & 3) * 32 + (lane & 3) * 8, k = (kk & ~0xC) | ((kk & 4) << 1) | ((kk & 8) >> 1);
    voff[i] = (unsigned)k * (unsigned)(tp.kstride * 2) + (unsigned)(c * 2); }
#define DMA_K(j, b) do { const char* kb_ = (const char*)tp.kp + (size_t)(j) * 128 * tp.kstride; \
    _Pragma("unroll") for (int i_ = 0; i_ < 2; ++i_) __builtin_amdgcn_global_load_lds((const unsigned*)(kb_ + koff[i_]), (ALAS unsigned*)(lds + OFF_K + (b) * 16384 + (2 * wid + i_) * 1024), 16, 0, 0); } while (0)
#define DMA_V(j, b) do { const char* vb_ = (const char*)tp.vp + (size_t)(j) * 128 * tp.kstride; \
    _Pragma("unroll") for (int h_ = 0; h_ < 2; ++h_) _Pragma("unroll") for (int i_ = 0; i_ < 2; ++i_) \
      __builtin_amdgcn_global_load_lds((const unsigned*)(vb_ + voff[i_] + h_ * 256), (ALAS unsigned*)(lds + OFF_V + ((b) * 2 + h_) * 16384 + (2 * wid + i_) * 1024), 16, 0, 0); } while (0)
  ALAS char* pmine = lds + OFF_P + (wid * 2) * 1024 + lane * 16;
  const ALAS char* ppart = lds + OFF_P + ((wid ^ 4) * 2) * 1024 + lane * 16;
  const ALAS char* krow_base = lds + OFF_K;
  bf16x8 m0 = {}, m1 = {};
  DMA_K(0, 0);
  for (int j = 0; j <= tp.nt; ++j) {
    asm volatile("s_waitcnt vmcnt(0)" ::: "memory"); __syncthreads();
    if (j + 1 < tp.nt) DMA_K(j + 1, (j + 1) & 1);
    if (j < tp.nt) DMA_V(j, j & 1);
    bf16x8 n0 = m0, n1 = m1;
#define S_STEP() do {                                                                                                          \
      f32x16 p, pB_; for (int r = 0; r < 16; ++r) { p[r] = 0.f; pB_[r] = 0.f; }                                               \
      bf16x8 kf[8]; const ALAS char* Ks = krow_base + (j & 1) * 16384;                                                         \
      _Pragma("unroll") for (int d0 = 0; d0 < 8; ++d0) kf[d0] = *(const ALAS bf16x8*)(Ks + KSWZ(32 * kh + r32, (d0 * 16 + hi * 8) * 2)); \
      asm volatile("s_waitcnt lgkmcnt(0)" ::: "memory"); ASBAR();                                                              \
      _Pragma("unroll") for (int d0 = 0; d0 < 8; d0 += 2) { p = __builtin_amdgcn_mfma_f32_32x32x16_bf16(kf[d0], qr[d0], p, 0, 0, 0); pB_ = __builtin_amdgcn_mfma_f32_32x32x16_bf16(kf[d0 + 1], qr[d0 + 1], pB_, 0, 0, 0); }   \
      _Pragma("unroll") for (int r = 0; r < 16; ++r) p[r] += pB_[r];                                                            \
      const float a = tp.fa - (float)(64 * j + 32 * kh);                                                                       \
      _Pragma("unroll") for (int r = 0; r < 16; ++r) p[r] = fmaf(-tp.slope, fabsf(a - (float)crow0(r)), p[r]);                 \
      if (tp.sh != 0.f) { _Pragma("unroll") for (int r = 0; r < 16; ++r) p[r] -= tp.sh; }                                      \
      _Pragma("unroll") for (int r = 0; r < 16; ++r) p[r] = __builtin_amdgcn_exp2f(p[r]);                                      \
      float ps = 0.f;                                                                                                          \
      _Pragma("unroll") for (int r = 0; r < 16; ++r) ps += p[r];                                                               \
      { auto rr = __builtin_amdgcn_permlane32_swap(__float_as_uint(ps), __float_as_uint(ps), false, false); ps = __uint_as_float(rr[0]) + __uint_as_float(rr[1]); } \
      l_reg += ps;                                                                                                             \
      PK4(p, 0, n0); PK4(p, 8, n1);                                                                                            \
      *(ALAS bf16x8*)(pmine + (j & 1) * 16384) = n0; *(ALAS bf16x8*)(pmine + (j & 1) * 16384 + 1024) = n1;                     \
    } while (0)
    if (kh == 1 && j < tp.nt) S_STEP();
    if (j > 0) {
      const int pb = (j - 1) & 1;
      const bf16x8 x0 = *(const ALAS bf16x8*)(ppart + pb * 16384), x1 = *(const ALAS bf16x8*)(ppart + pb * 16384 + 1024);
      const bool lo_half = (kh == 0);
      const bf16x8 pa0 = lo_half ? m0 : x0, pa1 = lo_half ? m1 : x1, pa2 = lo_half ? x0 : m0, pa3 = lo_half ? x1 : m1;
      pv_d0(o, vb0 + pb * 32768, pa0, pa1, pa2, pa3);
    }
    if (kh == 0 && j < tp.nt) S_STEP();
#undef S_STEP
    m0 = n0; m1 = n1;
  }
#undef PK4
#undef DMA_K
#undef DMA_V
  ALAS float* ssx = (ALAS float*)(lds + OFF_SSX);
  if (hi == 0) ssx[wid * 32 + r32] = l_reg;
  __syncthreads();
  l_reg += ssx[(wid ^ 4) * 32 + r32];
  __syncthreads();
}
__device__ __forceinline__ void row_bcast(ALAS char* lds, int wid, int r32, int hi, float v, float (&out)[16]) {
  ALAS float* li_l = (ALAS float*)(lds + OFF_WS) + wid * 64;
  if (hi == 0) li_l[r32] = v; asm volatile("s_waitcnt lgkmcnt(0)" ::: "memory");
#pragma unroll
  for (int r = 0; r < 16; ++r) out[r] = li_l[crow(r, hi)];
  asm volatile("s_waitcnt lgkmcnt(0)" ::: "memory");
}
__device__ __forceinline__ float swz_xor(float v, int) = delete;
template <int MASK> __device__ __forceinline__ float swz_xor(float v) { return __int_as_float(__builtin_amdgcn_ds_swizzle(__float_as_int(v), 0x1f | (MASK << 10))); }
__device__ __forceinline__ float half_sum(float v) {
  v += swz_xor<1>(v); v += swz_xor<2>(v); v += swz_xor<4>(v); v += swz_xor<8>(v); v += swz_xor<16>(v);
  return v;
}
__device__ __forceinline__ float wave_sum_sw(float v) {
  v = half_sum(v); auto rr = __builtin_amdgcn_permlane32_swap(__float_as_uint(v), __float_as_uint(v), false, false); return __uint_as_float(rr[0]) + __uint_as_float(rr[1]);
}
__device__ __forceinline__ float wave_max_sw(float v) {
  v = fmaxf(v, swz_xor<1>(v)); v = fmaxf(v, swz_xor<2>(v)); v = fmaxf(v, swz_xor<4>(v)); v = fmaxf(v, swz_xor<8>(v)); v = fmaxf(v, swz_xor<16>(v));
  auto rr = __builtin_amdgcn_permlane32_swap(__float_as_uint(v), __float_as_uint(v), false, false); return fmaxf(__uint_as_float(rr[0]), __uint_as_float(rr[1]));
}
}
constexpr int NWAVES = 8;
constexpr int BATCH = 2, SEQ = 4096, D = 4096, M = BATCH * SEQ, INW = 12288, FF = 11008, NLAYER = 2;
constexpr int NIN = 22;
#ifndef F8_DOWN
#define F8_DOWN 2
#endif
constexpr float RMS_EPS = 1e-6f;

constexpr float QSCALE = 0.08838834764831845f * att::LOG2E;
constexpr int C_QA = 0, C_KA = 1024, C_VA = 2048, C_QB = 3072, C_KB = 4608, C_VB = 6144, C_QC = 7680, C_KC = 9216, C_VC = 10752;
constexpr size_t MiB = 1u << 20;
constexpr size_t WS_CTL = 0, CTL_ZERO_BYTES = 1 * MiB;
constexpr size_t WSZ_WIN = (size_t)INW * D * 2, WSZ_WOUT = (size_t)D * D * 2, WSZ_WGU = (size_t)2 * FF * D * 2, WSZ_WDN = (size_t)D * FF * 2, WSZ_LAYER = WSZ_WIN + WSZ_WOUT + WSZ_WGU + WSZ_WDN;
constexpr size_t WS_W = 1 * MiB;
constexpr size_t WS_H = WS_W + NLAYER * WSZ_LAYER;
constexpr size_t WS_PROJ = WS_H + (size_t)M * D * 2;
constexpr size_t WS_MIX = WS_PROJ + (size_t)M * INW * 2;
constexpr size_t WS_CO = WS_MIX + (size_t)M * D * 2;
constexpr size_t WS_LSE = WS_CO + (size_t)3 * M * 1536 * 2;
constexpr size_t WS_PS = WS_LSE + 2 * MiB;
constexpr size_t WS_X0 = WS_PS + (size_t)3 * M * 64 * 4;
constexpr size_t WS_X1 = WS_X0 + (size_t)M * D * 2;
constexpr size_t WS_SCRA = WS_X1 + (size_t)M * D * 2;
constexpr size_t WS_END = WS_SCRA + (size_t)256 * 128 * 256 * 4;
constexpr int CW_TMO = 0, CW_Q = 2048  , CW_BAR = 4096, CW_SS = 131072;
constexpr int RING_OFF = 0, RING_BYTES = 143360;
constexpr int LDSCTL_OFF = RING_BYTES, MISC_OFF = LDSCTL_OFF + 320;
constexpr int LDS_BYTES = 147456;
static_assert(att::ATT_LDS <= RING_BYTES, "attention LDS");
#define GAS __attribute__((address_space(1)))
#define LAS __attribute__((address_space(3)))
typedef unsigned short bf16;
typedef unsigned v4u __attribute__((ext_vector_type(4)));
typedef unsigned v2u __attribute__((ext_vector_type(2)));
typedef float f32x4 __attribute__((ext_vector_type(4)));
typedef short bf16x8 __attribute__((ext_vector_type(8)));
typedef GAS unsigned gu32;
#define RLX_AGENT __ATOMIC_RELAXED, __HIP_MEMORY_SCOPE_AGENT
#define LDS_WAIT() asm volatile("s_waitcnt lgkmcnt(0)" ::: "memory")
__device__ __forceinline__ unsigned f2bf(float f) { unsigned u = __builtin_bit_cast(unsigned, f); return (u + 0x7fffu + ((u >> 16) & 1u)) >> 16; }
__device__ __forceinline__ unsigned pk2(float lo, float hi) { return pg8::cvt_pk_bf16(lo, hi); }
__device__ __forceinline__ float bflo(unsigned w) { return __uint_as_float(w << 16); }
__device__ __forceinline__ float bfhi(unsigned w) { return __uint_as_float(w & 0xffff0000u); }
#define XB_TMO      128
#define XB_XCNT(j)  (256  + 64 * (j))
#define XB_XSUB(j)  (1280 + 64 * (j))
#define XB_XGEN(j)  (2304 + 64 * (j))
#define XB_TOP      3328
#define XB_TOPGEN   3392
#define XCD_BAR_WORDS 3456
#define XB_SPIN_CAP (1u << 18)

__device__ __forceinline__ unsigned xb_ld(unsigned* p)              { return __hip_atomic_load(p, __ATOMIC_RELAXED, __HIP_MEMORY_SCOPE_AGENT); }
__device__ __forceinline__ unsigned xb_add(unsigned* p, unsigned v) { return __hip_atomic_fetch_add(p, v, __ATOMIC_RELAXED, __HIP_MEMORY_SCOPE_AGENT); }
__device__ __forceinline__ unsigned xb_xcc_id() { return (unsigned)__builtin_amdgcn_s_getreg((3 << 11) | 20) & 0xFu; }
#define XB_SPIN(cond, bar) do { unsigned _sp = 0; while (cond) { __builtin_amdgcn_s_sleep(1); \
    if ((++_sp & 255u) == 0u) { if (xb_ld(&(bar)[XB_TMO])) break; if (_sp > XB_SPIN_CAP) { atomicAdd(&(bar)[XB_TMO], 1u); break; } } } } while (0)

struct XcdBarrier {
    unsigned* bar; unsigned x;
    volatile LAS unsigned* st;
};

__device__ __forceinline__ XcdBarrier xcd_barrier_post(unsigned* bar, volatile LAS unsigned* st) {
    XcdBarrier b; b.bar = bar; b.x = xb_xcc_id(); b.st = st;
    if (threadIdx.x == 0) (void)xb_add(&bar[XB_XCNT(b.x)], 1u);
    return b;
}
__device__ __forceinline__ void xcd_barrier_complete(unsigned* bar, unsigned x, unsigned& nloc, unsigned& nx) {
    const unsigned G = gridDim.x * gridDim.y * gridDim.z;
    unsigned sum, cnt, mine, sp = 0u;
    for (;;) {
        sum = 0u; cnt = 0u; mine = 0u;
#pragma unroll
        for (unsigned j = 0; j < 16; ++j) { const unsigned c = xb_ld(&bar[XB_XCNT(j)]); sum += c; cnt += (c > 0u) ? 1u : 0u; mine = (j == x) ? c : mine; }
        if (sum == G) break;
        __builtin_amdgcn_s_sleep(1);
        if ((++sp & 255u) == 0u) { if (xb_ld(&bar[XB_TMO])) break; if (sp > XB_SPIN_CAP) { atomicAdd(&bar[XB_TMO], 1u); break; } }
    }
    nloc = mine > 0u ? mine : 1u; nx = cnt > 0u ? cnt : 1u;
}

__device__ __forceinline__ void xcd_barrier(const XcdBarrier& b) {
    asm volatile("s_waitcnt vmcnt(0)" ::: "memory");
    __syncthreads();
    if (threadIdx.x == 0) {
        unsigned* bar = b.bar;
        __builtin_amdgcn_s_waitcnt(0);
        unsigned nloc = b.st[0], nx = b.st[1];
        if (nloc == 0u) { xcd_barrier_complete(bar, b.x, nloc, nx); b.st[0] = nloc; b.st[1] = nx; }
        const unsigned old = xb_add(&bar[XB_XSUB(b.x)], 1u);
        const unsigned gen = old / nloc;
        if (old + 1u == (gen + 1u) * nloc) {
            __builtin_amdgcn_fence(__ATOMIC_RELEASE, "agent");
            asm volatile("s_waitcnt vmcnt(0)" ::: "memory");
            const unsigned og = xb_add(&bar[XB_TOP], 1u);
            const unsigned tg = og / nx;
            if (og + 1u == (tg + 1u) * nx) xb_add(&bar[XB_TOPGEN], 1u);
            else XB_SPIN(xb_ld(&bar[XB_TOPGEN]) == tg, bar);
            __builtin_amdgcn_fence(__ATOMIC_ACQUIRE, "agent");
            xb_add(&bar[XB_XGEN(b.x)], 1u);
            asm volatile("s_waitcnt vmcnt(0)" ::: "memory");
        } else {
            XB_SPIN(xb_ld(&bar[XB_XGEN(b.x)]) == gen, bar);
            __builtin_amdgcn_fence(__ATOMIC_ACQUIRE, "agent");
            asm volatile("s_waitcnt vmcnt(0)" ::: "memory");
        }
    }
    __syncthreads();
}
__device__ __forceinline__ float wave_sum(float v) { return att::wave_sum_sw(v); }
template <bool F8 = false>
__device__ __forceinline__ void p0_transpose_item(const float* W, int K, int N, bf16* WT, int k0, int n0, int drow0, LAS float* scr, int lane, const float* gk) {
    const int c = lane & 7;
    f32x4 g0 = {1.f, 1.f, 1.f, 1.f}, g1 = g0;
    if (gk) { g0 = *(const GAS f32x4*)(gk + k0 + 8 * c); g1 = *(const GAS f32x4*)(gk + k0 + 8 * c + 4); }
    const float* wp = W + (size_t)k0 * N + n0 + lane;
    float v[64];
#pragma unroll
    for (int i = 0; i < 64; ++i) v[i] = wp[(size_t)i * N];
#pragma unroll
    for (int i = 0; i < 64; ++i) scr[i * 65 + lane] = v[i];
    LDS_WAIT(); asm volatile("" ::: "memory");
#pragma unroll
    for (int j = 0; j < 8; ++j) { const int n = (lane >> 3) + 8 * j; const LAS float* s = scr + (8 * c) * 65 + n;
        if constexpr (F8) {
            unsigned w0 = 0u, w1 = 0u;
#define W8V(x) __builtin_amdgcn_fmed3f(64.f * (x), -448.f, 448.f)
            w0 = __builtin_amdgcn_cvt_pk_fp8_f32(W8V(s[0 * 65]), W8V(s[1 * 65]), w0, false); w0 = __builtin_amdgcn_cvt_pk_fp8_f32(W8V(s[2 * 65]), W8V(s[3 * 65]), w0, true);
            w1 = __builtin_amdgcn_cvt_pk_fp8_f32(W8V(s[4 * 65]), W8V(s[5 * 65]), w1, false); w1 = __builtin_amdgcn_cvt_pk_fp8_f32(W8V(s[6 * 65]), W8V(s[7 * 65]), w1, true);
#undef W8V
            *(GAS v2u*)((unsigned char*)WT + (size_t)(drow0 + n) * K + k0 + 8 * c) = (v2u){w0, w1};
        } else {
        v4u o; o.x = pk2(s[0 * 65] * g0.x, s[1 * 65] * g0.y); o.y = pk2(s[2 * 65] * g0.z, s[3 * 65] * g0.w); o.z = pk2(s[4 * 65] * g1.x, s[5 * 65] * g1.y); o.w = pk2(s[6 * 65] * g1.z, s[7 * 65] * g1.w);
        *(GAS v4u*)(WT + (size_t)(drow0 + n) * K + k0 + 8 * c) = o; } }
    LDS_WAIT(); asm volatile("" ::: "memory");
}
constexpr int RSTAB_OFF = 139264;
__device__ __forceinline__ void build_rstab(LAS unsigned char* lds, const float* ps, int np, int pm, int tid) {
    LAS float* tab = (LAS float*)(lds + RSTAB_OFF);
    const int r = tid >> 1, half = tid & 1, h = np > 1 ? np / 2 : 1; const float* p = ps + (size_t)(pm * 256 + r) * np + half * h;
    float s = 0.f;
    if (np == 64) { const GAS f32x4* p4 = (const GAS f32x4*)p; f32x4 v[8];
#pragma unroll
        for (int i = 0; i < 8; ++i) v[i] = p4[i];
#pragma unroll
        for (int i = 0; i < 8; ++i) s += (v[i].x + v[i].y) + (v[i].z + v[i].w); }
    else if (np > 1 || half == 0) for (int i = 0; i < h; ++i) s += p[i];
    const float o = att::swz_xor<1>(s);
    const float tot = half ? o + s : s + o;
    if (half == 0) tab[r] = __builtin_amdgcn_rsqf(tot * (1.0f / 4096.0f) + 1e-6f);
    __syncthreads();
}
struct Args { const float* in[NIN]; float* out; unsigned char* ws; int ph_lo, ph_hi; };
static_assert(sizeof(Args) == NIN * 8 + 8 + 8 + 8, "Args has no padding");
constexpr int NPH_LAYER = 6, NPHASE = 1 + NLAYER * NPH_LAYER;
#define CAS __attribute__((address_space(4)))
#define INP(k) ((const float*)(const GAS float*)ap->in[k])
#ifndef MIX_DOWN
#define MIX_DOWN 0
#endif
#ifndef MIX_T8
#define MIX_T8 40
#endif
constexpr int MIXK8 = MIX_T8 * 128, MIX_PITCH = MIXK8 + 2 * (FF - MIXK8);
static_assert(MIX_T8 % 2 == 0 && MIXK8 % 128 == 0 && ((FF - MIXK8) / 64) % 2 == 0 && (FF - MIXK8) % 64 == 0 && MIXK8 % 64 == 0 && (MIX_PITCH & (MIX_PITCH - 1)) != 0 && (MIX_DOWN & F8_DOWN) == 0, "mixed-K split");
#ifndef MIX_GU
#define MIX_GU 2
#endif
#ifndef GU_T8
#define GU_T8 20
#endif
constexpr int GUK8 = GU_T8 * 128, GU_PITCH = GUK8 + 2 * (D - GUK8);
static_assert(GU_T8 % 2 == 0 && GUK8 % 256 == 0 && GUK8 < D && ((D - GUK8) / 64) % 2 == 0 && (GU_PITCH & (GU_PITCH - 1)) != 0 && (size_t)GU_PITCH <= (size_t)D * 2, "mixed-K gate|up split");
constexpr int I_IN = (D / 64) * (INW / 64), I_OUT = (D / 64) * (D / 64), I_G = (D / 64) * (FF / 64), I_DN = (FF / 64) * (D / 64);
constexpr int I_LAYER = I_IN + I_OUT + 2 * I_G + I_DN;
struct CvDesc { const float* src; unsigned char* dst; const float* gk; int N, pitch, f8; float gsel; };
__device__ __forceinline__ CvDesc cv_decode(int it, const CAS Args* ap, unsigned char* ws) {
    CvDesc d; const int l = it / I_LAYER; int r = it - l * I_LAYER;
    unsigned char* wl = ws + WS_W + (size_t)l * WSZ_LAYER;
    d.f8 = 0; d.gsel = 0.f; d.gk = INP(1);
    if (r < I_IN) { const int nblk = INW / 64, kb = r / nblk, nb = r % nblk; d.src = INP(2) + (size_t)l * D * INW + (size_t)(64 * kb) * INW + 64 * nb; d.N = INW; d.pitch = D * 2;
        d.dst = wl + ((size_t)(64 * nb) * D + 64 * kb) * 2; d.gk = INP(1) + (size_t)l * D + 64 * kb; d.gsel = 1.f; return d; } r -= I_IN;
    if (r < I_OUT) { const int nblk = D / 64, kb = r / nblk, nb = r % nblk; d.src = INP(17) + (size_t)l * D * D + (size_t)(64 * kb) * D + 64 * nb; d.N = D; d.pitch = D * 2;
        d.dst = wl + WSZ_WIN + ((size_t)(64 * nb) * D + 64 * kb) * 2; return d; } r -= I_OUT;
    if (r < 2 * I_G) { const int up = r >= I_G; if (up) r -= I_G; const int nblk = FF / 64, kb = r / nblk, nb = r % nblk, n0 = 64 * nb;
        d.src = INP(up ? 20 : 19) + (size_t)l * D * FF + (size_t)(64 * kb) * FF + n0; d.N = FF; d.pitch = D * 2;
        const size_t drow = (size_t)((n0 >> 7) * 256 + up * 128 + (n0 & 127)); d.gk = INP(18) + (size_t)l * D + 64 * kb; d.gsel = 1.f;
        if ((MIX_GU >> l) & 1) { d.pitch = GU_PITCH; const int k0 = 64 * kb;
            if (k0 < GUK8) { d.f8 = 1; d.dst = wl + WSZ_WIN + WSZ_WOUT + drow * GU_PITCH + k0; } else d.dst = wl + WSZ_WIN + WSZ_WOUT + drow * GU_PITCH + GUK8 + (size_t)(k0 - GUK8) * 2; }
        else d.dst = wl + WSZ_WIN + WSZ_WOUT + (drow * D + 64 * kb) * 2;
        return d; } r -= 2 * I_G;
    { const int nblk = D / 64, kb = r / nblk, nb = r % nblk; d.src = INP(21) + (size_t)l * FF * D + (size_t)(64 * kb) * D + 64 * nb; d.N = D;
      unsigned char* wd = wl + WSZ_WIN + WSZ_WOUT + WSZ_WGU;
      if ((F8_DOWN >> l) & 1) { d.f8 = 1; d.pitch = FF; d.dst = wd + (size_t)(64 * nb) * FF + 64 * kb; }
      else if ((MIX_DOWN >> l) & 1) { d.pitch = MIX_PITCH; const int k0 = 64 * kb;
          if (k0 < MIXK8) { d.f8 = 1; d.dst = wd + (size_t)(64 * nb) * MIX_PITCH + k0; } else d.dst = wd + (size_t)(64 * nb) * MIX_PITCH + MIXK8 + (size_t)(k0 - MIXK8) * 2; }
      else { d.pitch = FF * 2; d.dst = wd + ((size_t)(64 * nb) * FF + 64 * kb) * 2; } }
    return d;
}
#ifndef CV_NT
#define CV_NT 3
#endif
struct CvRegs { f32x4 v[16]; f32x4 g0, g1; };
__device__ __forceinline__ void cv_load(const CvDesc& d, int lane, CvRegs& R) {
    const float* wp = d.src + (size_t)(lane >> 4) * d.N + 4 * (lane & 15);
    R.g0 = *(const GAS f32x4*)(d.gk + 8 * (lane & 7)); R.g1 = *(const GAS f32x4*)(d.gk + 8 * (lane & 7) + 4);
#pragma unroll
#if (CV_NT & 1)
    for (int i = 0; i < 16; ++i) R.v[i] = __builtin_nontemporal_load((const GAS f32x4*)(wp + (size_t)(4 * i) * d.N));
#else
    for (int i = 0; i < 16; ++i) R.v[i] = *(const GAS f32x4*)(wp + (size_t)(4 * i) * d.N);
#endif
}
__device__ __forceinline__ void cv_finish(const CvDesc& d, int lane, const CvRegs& R, LAS float* scr) {
    { LAS float* w = scr + (lane >> 4) * 65 + 4 * (lane & 15);
#pragma unroll
      for (int i = 0; i < 16; ++i) { w[(4 * i) * 65 + 0] = R.v[i].x; w[(4 * i) * 65 + 1] = R.v[i].y; w[(4 * i) * 65 + 2] = R.v[i].z; w[(4 * i) * 65 + 3] = R.v[i].w; } }
    LDS_WAIT(); asm volatile("" ::: "memory");
    const int c = lane & 7; const bool hg = d.gsel != 0.f;
    const f32x4 one = {1.f, 1.f, 1.f, 1.f}; const f32x4 g0 = hg ? R.g0 : one, g1 = hg ? R.g1 : one;
    if (d.f8) {
#pragma unroll
        for (int j = 0; j < 8; ++j) { const int n = (lane >> 3) + 8 * j; const LAS float* s = scr + (8 * c) * 65 + n; unsigned w0 = 0u, w1 = 0u;
#define W8V(x) __builtin_amdgcn_fmed3f(64.f * (x), -448.f, 448.f)
            w0 = __builtin_amdgcn_cvt_pk_fp8_f32(W8V(s[0 * 65] * g0.x), W8V(s[1 * 65] * g0.y), w0, false); w0 = __builtin_amdgcn_cvt_pk_fp8_f32(W8V(s[2 * 65] * g0.z), W8V(s[3 * 65] * g0.w), w0, true);
            w1 = __builtin_amdgcn_cvt_pk_fp8_f32(W8V(s[4 * 65] * g1.x), W8V(s[5 * 65] * g1.y), w1, false); w1 = __builtin_amdgcn_cvt_pk_fp8_f32(W8V(s[6 * 65] * g1.z), W8V(s[7 * 65] * g1.w), w1, true);
#undef W8V
#if (CV_NT & 2)
            __builtin_nontemporal_store((v2u){w0, w1}, (GAS v2u*)(d.dst + (size_t)n * d.pitch + 8 * c)); }
#else
            *(GAS v2u*)(d.dst + (size_t)n * d.pitch + 8 * c) = (v2u){w0, w1}; }
#endif
    } else {
#pragma unroll
        for (int j = 0; j < 8; ++j) { const int n = (lane >> 3) + 8 * j; const LAS float* s = scr + (8 * c) * 65 + n;
            v4u o; o.x = pk2(s[0 * 65] * g0.x, s[1 * 65] * g0.y); o.y = pk2(s[2 * 65] * g0.z, s[3 * 65] * g0.w); o.z = pk2(s[4 * 65] * g1.x, s[5 * 65] * g1.y); o.w = pk2(s[6 * 65] * g1.z, s[7 * 65] * g1.w);
#if (CV_NT & 2)
            __builtin_nontemporal_store(o, (GAS v4u*)(d.dst + (size_t)n * d.pitch + 16 * c)); }
#else
            *(GAS v4u*)(d.dst + (size_t)n * d.pitch + 16 * c) = o; }
#endif
    }
    LDS_WAIT(); asm volatile("" ::: "memory");
}
template <int NI>
__device__ __forceinline__ void convert_run(int start, int step, const CAS Args* ap, unsigned char* ws, LAS float* scr, int lane) {
    static_assert(NI >= 2 && NI % 2 == 0, "even item count");
    CvRegs ra, rb; CvDesc da = cv_decode(start, ap, ws), db; cv_load(da, lane, ra);
#pragma unroll
    for (int k = 0; k + 2 < NI; k += 2) {
        db = cv_decode(start + (k + 1) * step, ap, ws); cv_load(db, lane, rb);
        cv_finish(da, lane, ra, scr);
        da = cv_decode(start + (k + 2) * step, ap, ws); cv_load(da, lane, ra);
        cv_finish(db, lane, rb, scr);
    }
    db = cv_decode(start + (NI - 1) * step, ap, ws); cv_load(db, lane, rb);
    cv_finish(da, lane, ra, scr);
    cv_finish(db, lane, rb, scr);
}
__device__ __forceinline__ void convert_run_n(int start, int n, const CAS Args* ap, unsigned char* ws, LAS float* scr, int lane) {
    CvRegs ra, rb; CvDesc da = cv_decode(start, ap, ws), db; cv_load(da, lane, ra);
#pragma unroll 1
    for (int k = 0; k + 2 < n; k += 2) {
        db = cv_decode(start + k + 1, ap, ws); cv_load(db, lane, rb);
        cv_finish(da, lane, ra, scr);
        da = cv_decode(start + k + 2, ap, ws); cv_load(da, lane, ra);
        cv_finish(db, lane, rb, scr);
    }
    db = cv_decode(start + n - 1, ap, ws); cv_load(db, lane, rb);
    cv_finish(da, lane, ra, scr);
    cv_finish(db, lane, rb, scr);
}
#ifndef CV_RUN
#define CV_RUN 16
#endif
__device__ __forceinline__ bool convert_long(gu32* qv, int first, int nitems, const CAS Args* ap, unsigned char* ws, LAS float* scr, int lane) {
    int base = 0; if (lane == 0) base = (int)__hip_atomic_fetch_add(qv, (unsigned)CV_RUN, RLX_AGENT);
    base = __builtin_amdgcn_readfirstlane(base);
    if (base >= nitems) return false;
    const int n = nitems - base < CV_RUN ? nitems - base : CV_RUN;
    convert_run_n(first + base, n, ap, ws, scr, lane);
    return true;
}
#ifndef CV_R
#define CV_R 4
#endif
__device__ __forceinline__ bool convert_some(gu32* qv, int first, int nitems, const CAS Args* ap, unsigned char* ws, LAS float* scr, int lane) {
    int base = 0; if (lane == 0) base = (int)__hip_atomic_fetch_add(qv, (unsigned)CV_R, RLX_AGENT);
    base = __builtin_amdgcn_readfirstlane(base);
    if (base >= nitems) return false;
    convert_run<CV_R>(first + base, 1, ap, ws, scr, lane);
    return true;
}


__global__ void __launch_bounds__(NWAVES * 64, 2) mega_fwd(Args args) {
    extern __shared__ __attribute__((aligned(16))) unsigned char lds_raw[];
    LAS unsigned char* lds = (LAS unsigned char*)lds_raw;
    volatile LAS unsigned* MISC = (volatile LAS unsigned*)(lds + MISC_OFF);
    const int wave = __builtin_amdgcn_readfirstlane((int)threadIdx.x >> 6);
#define PHASE_TID() int tid = threadIdx.x; asm volatile("" : "+v"(tid)); const int lane = tid & 63; (void)lane
    const int G = gridDim.x; const int bx = blockIdx.x;
    const int vcu = (G % 8 == 0) ? (bx % 8) * (G / 8) + bx / 8 : bx;
    gu32* ctl = (gu32*)(args.ws + WS_CTL);
    for (int u = threadIdx.x; u < (LDS_BYTES - LDSCTL_OFF) / 4; u += NWAVES * 64) ((LAS unsigned*)(lds + LDSCTL_OFF))[u] = 0u;
    __syncthreads();
    const int lo = args.ph_lo, hi_ph = args.ph_hi;
    const bool use_bar = (hi_ph - lo) > 1;
    XcdBarrier bar; bar.bar = (unsigned*)(ctl + CW_BAR); bar.x = 0; bar.st = nullptr;
    if (use_bar) bar = xcd_barrier_post((unsigned*)(ctl + CW_BAR), MISC + 8);
#ifndef ATT_EN
#define ATT_EN 7
#endif
#ifndef ATT_REP
#define ATT_REP 0
#endif
#ifndef PHMASK
#define PHMASK 0x3ff
#endif
#define EN(k) (((PHMASK) >> (k)) & 1)
#ifndef PHREP
#define PHREP 0
#endif
#define REP(k) (((PHREP) >> (k)) & 1)
#define IN(k) (lo <= (k) && (k) < hi_ph)
#define SEAM(k) do { if (IN(k) && IN((k) + 1)) xcd_barrier(bar); } while (0)
#define CAS __attribute__((address_space(4)))
#define INP(k) ((const float*)(const GAS float*)ap->in[k])
#define PHASE_PTRS() const CAS Args* ap = (const CAS Args*)__builtin_amdgcn_kernarg_segment_ptr(); asm volatile("" : "+s"(ap)); unsigned char* const ws = (unsigned char*)(GAS unsigned char*)ap->ws; \
    bf16* const Hb = (bf16*)(ws + WS_H); bf16* const PROJ = (bf16*)(ws + WS_PROJ); bf16* const ACT = (bf16*)(ws + WS_PROJ); bf16* const MIX = (bf16*)(ws + WS_MIX); \
    bf16* const CO = (bf16*)(ws + WS_CO); float* const LSE = (float*)(ws + WS_LSE); bf16* const X0 = (bf16*)(ws + WS_X0); bf16* const X1 = (bf16*)(ws + WS_X1); float* const SCRA = (float*)(ws + WS_SCRA); \
    const bf16* wl = (const bf16*)(ws + WS_W + (size_t)l * WSZ_LAYER); \
    const bf16* W_IN = wl; const bf16* W_OUT = (const bf16*)((const char*)wl + WSZ_WIN); const bf16* W_GU = (const bf16*)((const char*)wl + WSZ_WIN + WSZ_WOUT); const bf16* W_DN = (const bf16*)((const char*)wl + WSZ_WIN + WSZ_WOUT + WSZ_WGU); \
    float* const SSQ = (float*)(ws + WS_CTL) + CW_SS; float* const PSQ = (float*)(ws + WS_PS); (void)SSQ; (void)PSQ; \
    float* const xout = (float*)(GAS float*)ap->out; \
    (void)Hb; (void)PROJ; (void)ACT; (void)MIX; (void)CO; (void)LSE; (void)X0; (void)X1; (void)SCRA; (void)W_IN; (void)W_OUT; (void)W_GU; (void)W_DN; (void)xout
    const int gw = vcu * NWAVES + wave, NGW = G * NWAVES;

    for (int rep_ = 0; rep_ < 1 + REP(0); ++rep_) if (EN(0) && IN(0)) { PHASE_TID(); const CAS Args* ap = (const CAS Args*)__builtin_amdgcn_kernarg_segment_ptr(); asm volatile("" : "+s"(ap)); unsigned char* const ws = (unsigned char*)(GAS unsigned char*)ap->ws;
        LAS float* scr = (LAS float*)(lds + RING_OFF + wave * 16640);
        static_assert(I_IN % (256 * NWAVES * 2) == 0, "prologue items per wave");
        if (NGW == 256 * NWAVES) convert_run<I_IN / (256 * NWAVES)>(gw, NGW, ap, ws, scr, lane);
        else for (int it = 2 * gw; it < I_IN; it += 2 * NGW) convert_run<2>(it, 1, ap, ws, scr, lane);
        { bf16* const Hb = (bf16*)(ws + WS_X0); float* const SSQ = (float*)(ws + WS_CTL) + CW_SS; const float* x0 = INP(0);
          for (int m = gw; m < M; m += NGW) {
            const GAS f32x4* xr = (const GAS f32x4*)(x0 + (size_t)m * D) + lane; f32x4 v[16]; float s = 0.f;
#pragma unroll
            for (int j = 0; j < 16; ++j) { v[j] = xr[64 * j]; s += (v[j].x * v[j].x + v[j].y * v[j].y) + (v[j].z * v[j].z + v[j].w * v[j].w); }
            s = wave_sum(s); if (lane == 0) SSQ[m] = s;
            GAS v2u* o8 = (GAS v2u*)(Hb + (size_t)m * D) + lane;
#pragma unroll
            for (int j = 0; j < 16; ++j) { v2u w; w.x = pk2(v[j].x, v[j].y); w.y = pk2(v[j].z, v[j].w); o8[64 * j] = w; }
          } }
    }
    SEAM(0);
    {
        constexpr int l = 0;
        const int pb = 1 + NPH_LAYER * l;
        for (int rep_ = 0; rep_ < 1 + REP(1); ++rep_) if (EN(1) && IN(pb + 0)) { PHASE_TID(); PHASE_PTRS();
            pg8::Gemm g{X0, W_IN, M, INW, D}; pg8::StaticOrder S; S.init(M, INW, G, (int)blockIdx.x);
            const float* psrc = (l == 0) ? SSQ : PSQ + (size_t)(2 * l - 1) * M * 64; const int pnp = (l == 0) ? 1 : 64;
            pg8::Unit u0; (void)S.next(0, u0); build_rstab(lds, psrc, pnp, u0.pm, tid);
            pg8::EpiProj E{PROJ, INW, pg8::RowScale{(const LAS float*)(lds + RSTAB_OFF), u0.pm, psrc, pnp}, INP(3) + l * 128, INP(4) + l * 128, INP(10) + l * 128, INP(11) + l * 128, INP(14) + l * 128, INP(15) + l * 128, QSCALE, (LAS float*)(lds + 131072)};
            pg8::gemm_phase<pg8::EpiProj, pg8::StaticOrder, true, true>(lds + RING_OFF, g, S, E);
        }
        SEAM(pb + 0);
        for (int rep_ = 0; rep_ < 1 + REP(2); ++rep_) if (EN(2) && IN(pb + 1)) { PHASE_TID(); PHASE_PTRS();
            using namespace att;
            const int wid = wave;
            float shA, shB, shC, bAu;
            { float ga = fmaxf(fabsf(INP(3)[l * 128 + lane]), fabsf(INP(3)[l * 128 + 64 + lane])), gk = fmaxf(fabsf(INP(4)[l * 128 + lane]), fabsf(INP(4)[l * 128 + 64 + lane]));
              float gb = fmaxf(fabsf(INP(10)[l * 128 + lane]), fabsf(INP(10)[l * 128 + 64 + lane])), gkb = fmaxf(fabsf(INP(11)[l * 128 + lane]), fabsf(INP(11)[l * 128 + 64 + lane]));
              float gc = fmaxf(fabsf(INP(14)[l * 128 + lane]), fabsf(INP(14)[l * 128 + 64 + lane])), gkc = fmaxf(fabsf(INP(15)[l * 128 + lane]), fabsf(INP(15)[l * 128 + 64 + lane]));
              float rb = 0.f; for (int e = lane; e < 12 * 15 * 31; e += 64) rb = fmaxf(rb, fabsf(INP(12)[(size_t)l * 12 * 15 * 31 + e]));
              ga = wave_max_sw(ga); gk = wave_max_sw(gk); gb = wave_max_sw(gb); gkb = wave_max_sw(gkb); gc = wave_max_sw(gc); gkc = wave_max_sw(gkc); rb = wave_max_sw(rb);
              const float bA = 128.f * QSCALE * ga * gk, bB = 128.f * QSCALE * gb * gkb + rb * LOG2E, bC = 128.f * QSCALE * gc * gkc;
              shA = bA > 64.f ? bA : 0.f; shB = bB > 64.f ? bB : 0.f; shC = bC > 64.f ? bC : 0.f;
              bAu = __int_as_float(__builtin_amdgcn_readfirstlane(__float_as_int(bA)));
              shA = __int_as_float(__builtin_amdgcn_readfirstlane(__float_as_int(shA))); shB = __int_as_float(__builtin_amdgcn_readfirstlane(__float_as_int(shB))); shC = __int_as_float(__builtin_amdgcn_readfirstlane(__float_as_int(shC))); }
            ALAS char* al = (ALAS char*)(lds + RING_OFF);
            gu32* const cvq = ctl + CW_Q + 64 * (4 + l);
            constexpr int cv_first = (l == 0) ? I_IN : I_LAYER + I_IN, cv_n = (l == 0) ? I_LAYER : I_LAYER - I_IN;
            static_assert(cv_n % CV_R == 0 && cv_first % 1 == 0, "queue length is a multiple of the per-visit item count");
#ifdef CV_SUBSET
#define CONVERT_FILL() do {} while (0)
#else
#define CONVERT_FILL() (void)convert_some(cvq, cv_first, cv_n, ap, ws, (LAS float*)(lds + RING_OFF + wave * 16640), tid & 63)
#endif
            const bool roles = (G == 256);
            const int xcd_ = vcu >> 5, li_ = vcu & 31, aj_ = (li_ >> 2) * 3 + (li_ & 3);
            const bool cvrole = roles && ((li_ & 3) == 3);
            if (cvrole) { while (convert_long(cvq, cv_first, cv_n, ap, ws, (LAS float*)(lds + RING_OFF + wave * 16640), tid & 63)) {} __syncthreads(); }
            const int nA_ = !roles ? (256 - vcu + G - 1) / G : cvrole ? 0 : aj_ < 16 ? 1 : 2;
            for (int rep2_ = 0; rep2_ < 1 + (ATT_REP & 1); ++rep2_) if (ATT_EN & 1) for (int ka_ = 0; ka_ < nA_; ++ka_) {
                asm volatile("" : "+v"(tid)); const int lane = tid & 63, r32 = lane & 31, hi = lane >> 5;
                int ua;
                if (roles) { const int hh = aj_ < 16 ? 2 + (aj_ >> 3) : 1 - ka_, qq = (xcd_ & 3) * 8 + (aj_ < 16 ? (aj_ & 7) : aj_ - 16); ua = ((xcd_ >> 2) << 7) + (hh << 5) + qq; }
                else { const int ua_ = vcu + ka_ * G; ua = ((ua_ >> 7) << 7) + (((ua_ >> 3) & 3) << 5) + (((ua_ >> 5) & 3) << 3) + (ua_ & 7); }
                const int b = ua >> 7, h = (ua >> 5) & 3, qb = ua & 31;
                const float lam_init = 0.8f - 0.6f * __builtin_amdgcn_exp2f(-0.3f * LOG2E * (float)l);
                float d1 = 0.f, d2 = 0.f;
                { const float* q1 = INP(5) + l * 128; const float* k1 = INP(6) + l * 128; const float* q2 = INP(7) + l * 128; const float* k2 = INP(8) + l * 128;
                  d1 = q1[lane] * k1[lane] + q1[lane + 64] * k1[lane + 64]; d2 = q2[lane] * k2[lane] + q2[lane + 64] * k2[lane + 64]; d1 = wave_sum_sw(d1); d2 = wave_sum_sw(d2); }
                const float lam = __builtin_amdgcn_exp2f(d1 * LOG2E) - __builtin_amdgcn_exp2f(d2 * LOG2E) + lam_init;
                const int wq = wid & 3, vh = wid >> 2;
                const int qtok = qb * 128 + wq * 32 + r32;
                const float slL = __builtin_amdgcn_exp2f(-2.0f * (float)(h + 1)) * LOG2E;
                const int Dh = (int)fminf((2.02f * bAu + 151.0f) / slL, 8192.0f) + 1;
                const int jlo = max(0, (qb * 128 - Dh) >> 6), jhi = min(SEQ / 64 - 1, (qb * 128 + 127 + Dh) >> 6);
                for (int pass = 0; pass < 2; ++pass) {
                    TileParams tp;
                    tp.qrow = PROJ + (size_t)(b * SEQ + qtok) * PITCH + C_QA + h * 256 + pass * 128 + hi * 8;
                    tp.kp = PROJ + (size_t)(b * SEQ + jlo * 64) * PITCH + C_KA + h * 256 + pass * 128;
                    tp.vp = PROJ + (size_t)(b * SEQ + jlo * 64) * PITCH + C_VA + h * 256;
                    tp.kstride = PITCH; tp.nt = jhi - jlo + 1; tp.jact_lo = 0; tp.jact_hi = SEQ / 64;
                    tp.fa = (float)(qtok - 4 * hi - 64 * jlo); tp.slope = slL; tp.tb = 0; tp.ucs = 0; tp.sh = shA;
                    f32x16 o[4]; float l_reg = 0.f;
#pragma unroll
                    for (int d = 0; d < 4; ++d) for (int r = 0; r < 16; ++r) o[d][r] = 0.f;
                    attn_tiles_A(al, tp, o, l_reg, tid);
                    int te = threadIdx.x; asm volatile("" : "+v"(te)); const int le = te & 63, r32 = le & 31, hi = le >> 5;
                    { float rli[16]; row_bcast(al, wid, r32, hi, __builtin_amdgcn_rcpf(l_reg), rli);
#pragma unroll
                      for (int d = 0; d < 4; ++d)
#pragma unroll
                          for (int r = 0; r < 16; ++r) o[d][r] *= rli[r]; }
                    float* scr = SCRA + (((size_t)ua * 8 + wid) * 64 + le) * 64;
                    const int obase = (b * SEQ + qb * 128 + wq * 32) * DM + h * 256 + vh * 128 + r32;
                    if (pass == 0) {
#pragma unroll
                        for (int d = 0; d < 4; ++d) {
#pragma unroll
                            for (int r = 0; r < 16; r += 4) *(GAS f32x4*)(scr + d * 16 + r) = (f32x4){o[d][r], o[d][r + 1], o[d][r + 2], o[d][r + 3]};
                            asm volatile("" ::: "memory"); }
                    } else {
                        ALAS float* ssx = (ALAS float*)(al + OFF_SSX);
                        float ss[16];
#pragma unroll
                        for (int d = 0; d < 4; ++d) {
#pragma unroll
                            for (int r = 0; r < 16; r += 4) { const f32x4 t = *(const GAS f32x4*)(scr + d * 16 + r);
#pragma unroll
                                for (int q = 0; q < 4; ++q) o[d][r + q] = t[q] - lam * o[d][r + q]; }
                            asm volatile("" ::: "memory"); }
#pragma unroll
                        for (int r = 0; r < 16; ++r) { float s = 0.f;
#pragma unroll
                            for (int d = 0; d < 4; ++d) s += o[d][r] * o[d][r];
                            ss[r] = half_sum(s); }
                        if (r32 == 0) {
#pragma unroll
                            for (int r = 0; r < 16; ++r) ssx[wid * 32 + crow(r, hi)] = ss[r]; }
                        __syncthreads();
                        const float* go = INP(9) + (size_t)l * 256 + vh * 128;
                        const float osc = 1.0f - lam_init;
#pragma unroll
                        for (int r = 0; r < 16; ++r) { const int row = crow(r, hi); const float tot = ss[r] + ssx[(wid ^ 4) * 32 + row];
                            const float rs = (__builtin_amdgcn_rsqf(tot * (1.f / 256.f) + RMS_EPS)) * osc;
                            bf16* orow = MIX + (size_t)(obase + row * DM);
#pragma unroll
                            for (int d = 0; d < 4; ++d) orow[d * 32] = att::f2bf(o[d][r] * rs * go[d * 32 + r32]); }
                        __syncthreads();
                    }
                }
            }
            if (ATT_EN & 2) {
                gu32* qhead = ctl + CW_Q + 64 * (2 * l);
                volatile LAS unsigned* qslot = MISC + 16;
                unsigned nxt = 0u;
                if (tid == 0) nxt = __hip_atomic_fetch_add(qhead, 1u, RLX_AGENT);
                for (;;) {
                    if (tid == 0) qslot[0] = nxt;
                    __syncthreads();
                    const int ub = (int)qslot[0];
                    __syncthreads();
                    if (ub >= 384) break;
                    if (tid == 0) nxt = __hip_atomic_fetch_add(qhead, 1u, RLX_AGENT);
                    asm volatile("" : "+v"(tid)); const int lane = tid & 63, r32 = lane & 31, hi = lane >> 5;
                    const int b = ub / 192, h = (ub / 16) % 12, rg = ub % 16, r0 = 4 * rg;
                    const int i0 = min(max(r0 - 4, 0), 56), i1 = min(max(r0 + 3 - 4, 0), 56) + 7;
                    { ALAS float* tab = (ALAS float*)(al + OFF_TAB); const float* rp = INP(12) + ((size_t)l * 12 + h) * 15 * 31;
                      for (int e = tid; e < 15 * 128; e += NWAVES * 64) { const int dr = e >> 7, x = (e & 127) - 48; tab[e] = (x >= 0 && x < 31) ? rp[dr * 31 + x] * LOG2E - shB : 0.f; } }
                    const int rq = r0 + (wid >> 1), c = (wid & 1) * 32 + r32;
                    const int rs_ = min(max(rq - 4, 0), 56), cs = min(max(c - 8, 0), 48);
                    TileParams tp;
                    tp.qrow = PROJ + (size_t)(b * SEQ + r0 * 64 + wid * 32 + r32) * PITCH + C_QB + h * 128 + hi * 8;
                    tp.kp = PROJ + (size_t)(b * SEQ + i0 * 64) * PITCH + C_KB + h * 128;
                    tp.vp = PROJ + (size_t)(b * SEQ + i0 * 64) * PITCH + C_VB + h * 128;
                    tp.kstride = PITCH; tp.nt = i1 - i0 + 1; tp.jact_lo = rs_ - i0; tp.jact_hi = rs_ + 7 - i0;
                    tp.fa = 0.f; tp.slope = 0.f; tp.tb = (i0 - rq + 7) * 128 + 48 + 15 + 4 * hi - c; tp.ucs = 4 * hi - cs; tp.sh = shB;
                    f32x16 o[4]; float l_reg = 0.f;
#pragma unroll
                    for (int d = 0; d < 4; ++d) for (int r = 0; r < 16; ++r) o[d][r] = 0.f;
                    attn_tiles<1>(al, tp, o, l_reg, tid);
                    float rli[16]; row_bcast(al, wid, r32, hi, __builtin_amdgcn_rcpf(l_reg), rli);
                    const float* go = INP(13) + (size_t)l * 128;
#pragma unroll
                    for (int r = 0; r < 16; ++r) { float s = 0.f; float v[4];
#pragma unroll
                        for (int d = 0; d < 4; ++d) { v[d] = o[d][r] * rli[r]; s += v[d] * v[d]; }
                        s = half_sum(s); const float rs = __builtin_amdgcn_rsqf(s * (1.f / 128.f) + RMS_EPS);
                        bf16* orow = MIX + (size_t)(b * SEQ + r0 * 64 + wid * 32 + crow(r, hi)) * DM + 1024 + h * 128 + r32;
#pragma unroll
                        for (int d = 0; d < 4; ++d) orow[d * 32] = att::f2bf(v[d] * rs * go[d * 32 + r32]); }
                    __syncthreads();
#ifdef CV_FILL
                    CONVERT_FILL();
#endif
                }
            }
            if (ATT_EN & 4) {
                gu32* qhead = ctl + CW_Q + 64 * (2 * l + 1);
                volatile LAS unsigned* qslot = MISC + 16;
                unsigned nxt = 0u;
                if (tid == 0) nxt = __hip_atomic_fetch_add(qhead, 1u, RLX_AGENT);
                for (;;) {
                    if (tid == 0) qslot[0] = nxt;
                    __syncthreads();
                    const int uc = (int)qslot[0];
                    __syncthreads();
                    if (uc >= 1152) break;
                    if (tid == 0) nxt = __hip_atomic_fetch_add(qhead, 1u, RLX_AGENT);
                    asm volatile("" : "+v"(tid)); const int lane = tid & 63, r32 = lane & 31, hi = lane >> 5;
                    const int b = uc / 576, h = (uc / 48) % 12, x = uc % 48, gbr = x >> 4, idx = x & 15;
                    const int dil = gbr == 0 ? 1 : gbr == 1 ? 4 : 16, L = SEQ / dil;
                    const int rho = gbr == 0 ? 0 : gbr == 1 ? (idx >> 2) : idx, u0 = gbr == 0 ? idx * 256 : gbr == 1 ? (idx & 3) * 256 : 0;
                    const int jlo = (u0 == 0) ? 1 : 0, jhi = (u0 + 256 >= L) ? 4 : 5;
                    const int i_ = wid * 32 + r32;
                    TileParams tp;
                    tp.qrow = PROJ + (size_t)(b * SEQ + (u0 + i_) * dil + rho) * PITCH + C_QC + h * 128 + hi * 8;
                    const int uk0 = u0 - 64 + 64 * jlo;
                    tp.kp = PROJ + (size_t)(b * SEQ + uk0 * dil + rho) * PITCH + C_KC + h * 128;
                    tp.vp = PROJ + (size_t)(b * SEQ + uk0 * dil + rho) * PITCH + C_VC + h * 128;
                    tp.kstride = (size_t)PITCH * dil; tp.nt = jhi - jlo + 1; tp.jact_lo = (wid >> 1) - jlo; tp.jact_hi = (wid >> 1) + 2 - jlo;
                    tp.fa = (float)(i_ + 64 - 64 * jlo - 4 * hi); tp.slope = __builtin_amdgcn_exp2f((float)(h + 1) * (-8.0f / 12.0f)) * LOG2E * (float)dil; tp.tb = 0; tp.ucs = 0; tp.sh = shC;
                    f32x16 o[4]; float l_reg = 0.f;
#pragma unroll
                    for (int d = 0; d < 4; ++d) for (int r = 0; r < 16; ++r) o[d][r] = 0.f;
                    attn_tiles<2>(al, tp, o, l_reg, tid);
                    float rli[16]; row_bcast(al, wid, r32, hi, __builtin_amdgcn_rcpf(l_reg), rli);
                    bf16* cog = CO + (size_t)gbr * M * 1536;
#pragma unroll
                    for (int r = 0; r < 16; ++r) { bf16* orow = cog + (size_t)(b * SEQ + (u0 + wid * 32 + crow(r, hi)) * dil + rho) * 1536 + h * 128 + r32;
#pragma unroll
                        for (int d = 0; d < 4; ++d) orow[d * 32] = att::f2bf(o[d][r] * rli[r]); }
                    if (hi == 0) LSE[((size_t)gbr * M + b * SEQ + (u0 + i_) * dil + rho) * 12 + h] = __builtin_amdgcn_logf(l_reg);
                    __syncthreads();
#ifdef CV_FILL
                    CONVERT_FILL();
#endif
                }
            }
#ifdef CV_SUBSET
            if ((vcu % CV_SUBSET) == 0)
#endif
            while (convert_some(cvq, cv_first, cv_n, ap, ws, (LAS float*)(lds + RING_OFF + wave * 16640), tid & 63)) {}
        }
        SEAM(pb + 1);
        for (int rep_ = 0; rep_ < 1 + REP(3); ++rep_) if (EN(3) && IN(pb + 2)) { PHASE_TID(); PHASE_PTRS();
            const int hs = lane >> 4, sub = lane & 15;
            const float* go = INP(16) + (size_t)l * 128 + sub * 8;
            const f32x4 g0 = *(const GAS f32x4*)go, g1 = *(const GAS f32x4*)(go + 4);
            for (int it = gw; it < (M / 4) * 3; it += NGW) {
                const int rg = it / 3, ch = it - rg * 3, h = ch * 4 + hs;
                float ls[4][3]; v4u w[4][3];
#pragma unroll
                for (int q4 = 0; q4 < 4; ++q4)
#pragma unroll
                    for (int g = 0; g < 3; ++g) { const size_t row = (size_t)rg * 4 + q4; ls[q4][g] = LSE[((size_t)g * M + row) * 12 + h]; w[q4][g] = *(const GAS v4u*)(CO + ((size_t)g * M + row) * 1536 + h * 128 + sub * 8); }
#pragma unroll
                for (int q4 = 0; q4 < 4; ++q4) {
                    const float mx = fmaxf(ls[q4][0], fmaxf(ls[q4][1], ls[q4][2]));
                    float e[3], es = 0.f;
#pragma unroll
                    for (int g = 0; g < 3; ++g) { e[g] = __builtin_amdgcn_exp2f(ls[q4][g] - mx); es += e[g]; }
                    const float inv = __builtin_amdgcn_rcpf(es); float x[8];
#pragma unroll
                    for (int q = 0; q < 8; ++q) x[q] = 0.f;
#pragma unroll
                    for (int g = 0; g < 3; ++g) { const float wg = e[g] * inv; const unsigned ww[4] = {w[q4][g].x, w[q4][g].y, w[q4][g].z, w[q4][g].w};
#pragma unroll
                        for (int q = 0; q < 4; ++q) { x[2 * q] += wg * bflo(ww[q]); x[2 * q + 1] += wg * bfhi(ww[q]); } }
                    float s = 0.f;
#pragma unroll
                    for (int q = 0; q < 8; ++q) s += x[q] * x[q];
                    s += att::swz_xor<1>(s); s += att::swz_xor<2>(s); s += att::swz_xor<4>(s); s += att::swz_xor<8>(s);
                    const float rs = __builtin_amdgcn_rsqf(s * (1.f / 128.f) + RMS_EPS);
                    v4u o; o.x = pk2(x[0] * rs * g0.x, x[1] * rs * g0.y); o.y = pk2(x[2] * rs * g0.z, x[3] * rs * g0.w); o.z = pk2(x[4] * rs * g1.x, x[5] * rs * g1.y); o.w = pk2(x[6] * rs * g1.z, x[7] * rs * g1.w);
                    *(GAS v4u*)(MIX + ((size_t)rg * 4 + q4) * D + 2560 + h * 128 + sub * 8) = o; }
            }
        }
        SEAM(pb + 2);
        for (int rep_ = 0; rep_ < 1 + REP(4); ++rep_) if (EN(4) && IN(pb + 3)) { PHASE_TID(); PHASE_PTRS();
            pg8::Gemm g{MIX, W_OUT, M, D, D}; pg8::StaticOrder S; S.init(M, D, G, (int)blockIdx.x);
            constexpr bool xmix = (MIX_GU >> l) & 1; using ER = pg8::EpiRes<false, xmix ? GU_PITCH : 0, xmix ? GUK8 : 0>;
            ER E{X0, X1, nullptr, xmix ? ws + WS_H : nullptr, D, PSQ + (size_t)(2 * l) * M * 64, 1.0f};
            pg8::gemm_phase<ER, pg8::StaticOrder, true, true>(lds + RING_OFF, g, S, E);
        }
        SEAM(pb + 3);
        for (int rep_ = 0; rep_ < 1 + REP(5); ++rep_) if (EN(5) && IN(pb + 4)) { PHASE_TID(); PHASE_PTRS();
            constexpr int gmode = ((MIX_GU >> l) & 1) ? 2 : 0;
            pg8::Gemm g{gmode == 2 ? (const bf16*)(ws + WS_H) : X1, W_GU, M, 2 * FF, gmode == 2 ? GU_PITCH / 2 : D, gmode == 2 ? GU_T8 : 0}; pg8::StaticOrder S; S.init(M, 2 * FF, G, (int)blockIdx.x);
            const float* psrc = PSQ + (size_t)(2 * l) * M * 64;
            pg8::Unit u0; (void)S.next(0, u0); build_rstab(lds, psrc, 64, u0.pm, tid);
            if ((F8_DOWN >> l) & 1) { pg8::EpiSwiGLU<1> E{ACT, FF, FF, pg8::RowScale{(const LAS float*)(lds + RSTAB_OFF), u0.pm, psrc, 64}};
                pg8::gemm_phase<pg8::EpiSwiGLU<1>, pg8::StaticOrder, true, true, gmode>(lds + RING_OFF, g, S, E); }
            else if ((MIX_DOWN >> l) & 1) { pg8::EpiSwiGLU<2> E{ACT, MIX_PITCH, MIXK8, pg8::RowScale{(const LAS float*)(lds + RSTAB_OFF), u0.pm, psrc, 64}};
                pg8::gemm_phase<pg8::EpiSwiGLU<2>, pg8::StaticOrder, true, true, gmode>(lds + RING_OFF, g, S, E); }
            else { pg8::EpiSwiGLU<0> E{ACT, 2 * FF, 0, pg8::RowScale{(const LAS float*)(lds + RSTAB_OFF), u0.pm, psrc, 64}};
                pg8::gemm_phase<pg8::EpiSwiGLU<0>, pg8::StaticOrder, true, true, gmode>(lds + RING_OFF, g, S, E); }
        }
        SEAM(pb + 4);
        for (int rep_ = 0; rep_ < 1 + REP(6); ++rep_) if (EN(6) && IN(pb + 5)) { PHASE_TID(); PHASE_PTRS();
            constexpr int dmode = ((F8_DOWN >> l) & 1) ? 1 : ((MIX_DOWN >> l) & 1) ? 2 : 0;
            pg8::Gemm g{ACT, W_DN, M, D, dmode == 1 ? FF / 2 : dmode == 2 ? MIX_PITCH / 2 : FF, dmode == 2 ? MIX_T8 : 0}; pg8::StaticOrder S; S.init(M, D, G, (int)blockIdx.x);
            const float asc = dmode == 1 ? 1.0f / (16.0f * 64.0f) : 1.0f;
            if (l + 1 < NLAYER) { pg8::EpiRes<false> E{X1, X0, nullptr, nullptr, D, PSQ + (size_t)(2 * l + 1) * M * 64, asc};
                pg8::gemm_phase<pg8::EpiRes<false>, pg8::StaticOrder, true, true, dmode>(lds + RING_OFF, g, S, E); }
            else { pg8::EpiRes<true> E{X1, nullptr, xout, nullptr, D, nullptr, asc};
                pg8::gemm_phase<pg8::EpiRes<true>, pg8::StaticOrder, true, true, dmode>(lds + RING_OFF, g, S, E); }
        }
        SEAM(pb + 5);
    }
    {
        constexpr int l = 1;
        const int pb = 1 + NPH_LAYER * l;
        for (int rep_ = 0; rep_ < 1 + REP(1); ++rep_) if (EN(1) && IN(pb + 0)) { PHASE_TID(); PHASE_PTRS();
            pg8::Gemm g{X0, W_IN, M, INW, D}; pg8::StaticOrder S; S.init(M, INW, G, (int)blockIdx.x);
            const float* psrc = (l == 0) ? SSQ : PSQ + (size_t)(2 * l - 1) * M * 64; const int pnp = (l == 0) ? 1 : 64;
            pg8::Unit u0; (void)S.next(0, u0); build_rstab(lds, psrc, pnp, u0.pm, tid);
            pg8::EpiProj E{PROJ, INW, pg8::RowScale{(const LAS float*)(lds + RSTAB_OFF), u0.pm, psrc, pnp}, INP(3) + l * 128, INP(4) + l * 128, INP(10) + l * 128, INP(11) + l * 128, INP(14) + l * 128, INP(15) + l * 128, QSCALE, (LAS float*)(lds + 131072)};
            pg8::gemm_phase<pg8::EpiProj, pg8::StaticOrder, true, true>(lds + RING_OFF, g, S, E);
        }
        SEAM(pb + 0);
        for (int rep_ = 0; rep_ < 1 + REP(2); ++rep_) if (EN(2) && IN(pb + 1)) { PHASE_TID(); PHASE_PTRS();
            using namespace att;
            const int wid = wave;
            float shA, shB, shC, bAu;
            { float ga = fmaxf(fabsf(INP(3)[l * 128 + lane]), fabsf(INP(3)[l * 128 + 64 + lane])), gk = fmaxf(fabsf(INP(4)[l * 128 + lane]), fabsf(INP(4)[l * 128 + 64 + lane]));
              float gb = fmaxf(fabsf(INP(10)[l * 128 + lane]), fabsf(INP(10)[l * 128 + 64 + lane])), gkb = fmaxf(fabsf(INP(11)[l * 128 + lane]), fabsf(INP(11)[l * 128 + 64 + lane]));
              float gc = fmaxf(fabsf(INP(14)[l * 128 + lane]), fabsf(INP(14)[l * 128 + 64 + lane])), gkc = fmaxf(fabsf(INP(15)[l * 128 + lane]), fabsf(INP(15)[l * 128 + 64 + lane]));
              float rb = 0.f; for (int e = lane; e < 12 * 15 * 31; e += 64) rb = fmaxf(rb, fabsf(INP(12)[(size_t)l * 12 * 15 * 31 + e]));
              ga = wave_max_sw(ga); gk = wave_max_sw(gk); gb = wave_max_sw(gb); gkb = wave_max_sw(gkb); gc = wave_max_sw(gc); gkc = wave_max_sw(gkc); rb = wave_max_sw(rb);
              const float bA = 128.f * QSCALE * ga * gk, bB = 128.f * QSCALE * gb * gkb + rb * LOG2E, bC = 128.f * QSCALE * gc * gkc;
              shA = bA > 64.f ? bA : 0.f; shB = bB > 64.f ? bB : 0.f; shC = bC > 64.f ? bC : 0.f;
              bAu = __int_as_float(__builtin_amdgcn_readfirstlane(__float_as_int(bA)));
              shA = __int_as_float(__builtin_amdgcn_readfirstlane(__float_as_int(shA))); shB = __int_as_float(__builtin_amdgcn_readfirstlane(__float_as_int(shB))); shC = __int_as_float(__builtin_amdgcn_readfirstlane(__float_as_int(shC))); }
            ALAS char* al = (ALAS char*)(lds + RING_OFF);
            gu32* const cvq = ctl + CW_Q + 64 * (4 + l);
            constexpr int cv_first = (l == 0) ? I_IN : I_LAYER + I_IN, cv_n = (l == 0) ? I_LAYER : I_LAYER - I_IN;
            static_assert(cv_n % CV_R == 0 && cv_first % 1 == 0, "queue length is a multiple of the per-visit item count");
#ifdef CV_SUBSET
#define CONVERT_FILL() do {} while (0)
#else
#define CONVERT_FILL() (void)convert_some(cvq, cv_first, cv_n, ap, ws, (LAS float*)(lds + RING_OFF + wave * 16640), tid & 63)
#endif
            const bool roles = (G == 256);
            const int xcd_ = vcu >> 5, li_ = vcu & 31, aj_ = (li_ >> 2) * 3 + (li_ & 3);
            const bool cvrole = roles && ((li_ & 3) == 3);
            if (cvrole) { while (convert_long(cvq, cv_first, cv_n, ap, ws, (LAS float*)(lds + RING_OFF + wave * 16640), tid & 63)) {} __syncthreads(); }
            const int nA_ = !roles ? (256 - vcu + G - 1) / G : cvrole ? 0 : aj_ < 16 ? 1 : 2;
            for (int rep2_ = 0; rep2_ < 1 + (ATT_REP & 1); ++rep2_) if (ATT_EN & 1) for (int ka_ = 0; ka_ < nA_; ++ka_) {
                asm volatile("" : "+v"(tid)); const int lane = tid & 63, r32 = lane & 31, hi = lane >> 5;
                int ua;
                if (roles) { const int hh = aj_ < 16 ? 2 + (aj_ >> 3) : 1 - ka_, qq = (xcd_ & 3) * 8 + (aj_ < 16 ? (aj_ & 7) : aj_ - 16); ua = ((xcd_ >> 2) << 7) + (hh << 5) + qq; }
                else { const int ua_ = vcu + ka_ * G; ua = ((ua_ >> 7) << 7) + (((ua_ >> 3) & 3) << 5) + (((ua_ >> 5) & 3) << 3) + (ua_ & 7); }
                const int b = ua >> 7, h = (ua >> 5) & 3, qb = ua & 31;
                const float lam_init = 0.8f - 0.6f * __builtin_amdgcn_exp2f(-0.3f * LOG2E * (float)l);
                float d1 = 0.f, d2 = 0.f;
                { const float* q1 = INP(5) + l * 128; const float* k1 = INP(6) + l * 128; const float* q2 = INP(7) + l * 128; const float* k2 = INP(8) + l * 128;
                  d1 = q1[lane] * k1[lane] + q1[lane + 64] * k1[lane + 64]; d2 = q2[lane] * k2[lane] + q2[lane + 64] * k2[lane + 64]; d1 = wave_sum_sw(d1); d2 = wave_sum_sw(d2); }
                const float lam = __builtin_amdgcn_exp2f(d1 * LOG2E) - __builtin_amdgcn_exp2f(d2 * LOG2E) + lam_init;
                const int wq = wid & 3, vh = wid >> 2;
                const int qtok = qb * 128 + wq * 32 + r32;
                const float slL = __builtin_amdgcn_exp2f(-2.0f * (float)(h + 1)) * LOG2E;
                const int Dh = (int)fminf((2.02f * bAu + 151.0f) / slL, 8192.0f) + 1;
                const int jlo = max(0, (qb * 128 - Dh) >> 6), jhi = min(SEQ / 64 - 1, (qb * 128 + 127 + Dh) >> 6);
                for (int pass = 0; pass < 2; ++pass) {
                    TileParams tp;
                    tp.qrow = PROJ + (size_t)(b * SEQ + qtok) * PITCH + C_QA + h * 256 + pass * 128 + hi * 8;
                    tp.kp = PROJ + (size_t)(b * SEQ + jlo * 64) * PITCH + C_KA + h * 256 + pass * 128;
                    tp.vp = PROJ + (size_t)(b * SEQ + jlo * 64) * PITCH + C_VA + h * 256;
                    tp.kstride = PITCH; tp.nt = jhi - jlo + 1; tp.jact_lo = 0; tp.jact_hi = SEQ / 64;
                    tp.fa = (float)(qtok - 4 * hi - 64 * jlo); tp.slope = slL; tp.tb = 0; tp.ucs = 0; tp.sh = shA;
                    f32x16 o[4]; float l_reg = 0.f;
#pragma unroll
                    for (int d = 0; d < 4; ++d) for (int r = 0; r < 16; ++r) o[d][r] = 0.f;
                    attn_tiles_A(al, tp, o, l_reg, tid);
                    int te = threadIdx.x; asm volatile("" : "+v"(te)); const int le = te & 63, r32 = le & 31, hi = le >> 5;
                    { float rli[16]; row_bcast(al, wid, r32, hi, __builtin_amdgcn_rcpf(l_reg), rli);
#pragma unroll
                      for (int d = 0; d < 4; ++d)
#pragma unroll
                          for (int r = 0; r < 16; ++r) o[d][r] *= rli[r]; }
                    float* scr = SCRA + (((size_t)ua * 8 + wid) * 64 + le) * 64;
                    const int obase = (b * SEQ + qb * 128 + wq * 32) * DM + h * 256 + vh * 128 + r32;
                    if (pass == 0) {
#pragma unroll
                        for (int d = 0; d < 4; ++d) {
#pragma unroll
                            for (int r = 0; r < 16; r += 4) *(GAS f32x4*)(scr + d * 16 + r) = (f32x4){o[d][r], o[d][r + 1], o[d][r + 2], o[d][r + 3]};
                            asm volatile("" ::: "memory"); }
                    } else {
                        ALAS float* ssx = (ALAS float*)(al + OFF_SSX);
                        float ss[16];
#pragma unroll
                        for (int d = 0; d < 4; ++d) {
#pragma unroll
                            for (int r = 0; r < 16; r += 4) { const f32x4 t = *(const GAS f32x4*)(scr + d * 16 + r);
#pragma unroll
                                for (int q = 0; q < 4; ++q) o[d][r + q] = t[q] - lam * o[d][r + q]; }
                            asm volatile("" ::: "memory"); }
#pragma unroll
                        for (int r = 0; r < 16; ++r) { float s = 0.f;
#pragma unroll
                            for (int d = 0; d < 4; ++d) s += o[d][r] * o[d][r];
                            ss[r] = half_sum(s); }
                        if (r32 == 0) {
#pragma unroll
                            for (int r = 0; r < 16; ++r) ssx[wid * 32 + crow(r, hi)] = ss[r]; }
                        __syncthreads();
                        const float* go = INP(9) + (size_t)l * 256 + vh * 128;
                        const float osc = 1.0f - lam_init;
#pragma unroll
                        for (int r = 0; r < 16; ++r) { const int row = crow(r, hi); const float tot = ss[r] + ssx[(wid ^ 4) * 32 + row];
                            const float rs = (__builtin_amdgcn_rsqf(tot * (1.f / 256.f) + RMS_EPS)) * osc;
                            bf16* orow = MIX + (size_t)(obase + row * DM);
#pragma unroll
                            for (int d = 0; d < 4; ++d) orow[d * 32] = att::f2bf(o[d][r] * rs * go[d * 32 + r32]); }
                        __syncthreads();
                    }
                }
            }
            if (ATT_EN & 2) {
                gu32* qhead = ctl + CW_Q + 64 * (2 * l);
                volatile LAS unsigned* qslot = MISC + 16;
                unsigned nxt = 0u;
                if (tid == 0) nxt = __hip_atomic_fetch_add(qhead, 1u, RLX_AGENT);
                for (;;) {
                    if (tid == 0) qslot[0] = nxt;
                    __syncthreads();
                    const int ub = (int)qslot[0];
                    __syncthreads();
                    if (ub >= 384) break;
                    if (tid == 0) nxt = __hip_atomic_fetch_add(qhead, 1u, RLX_AGENT);
                    asm volatile("" : "+v"(tid)); const int lane = tid & 63, r32 = lane & 31, hi = lane >> 5;
                    const int b = ub / 192, h = (ub / 16) % 12, rg = ub % 16, r0 = 4 * rg;
                    const int i0 = min(max(r0 - 4, 0), 56), i1 = min(max(r0 + 3 - 4, 0), 56) + 7;
                    { ALAS float* tab = (ALAS float*)(al + OFF_TAB); const float* rp = INP(12) + ((size_t)l * 12 + h) * 15 * 31;
                      for (int e = tid; e < 15 * 128; e += NWAVES * 64) { const int dr = e >> 7, x = (e & 127) - 48; tab[e] = (x >= 0 && x < 31) ? rp[dr * 31 + x] * LOG2E - shB : 0.f; } }
                    const int rq = r0 + (wid >> 1), c = (wid & 1) * 32 + r32;
                    const int rs_ = min(max(rq - 4, 0), 56), cs = min(max(c - 8, 0), 48);
                    TileParams tp;
                    tp.qrow = PROJ + (size_t)(b * SEQ + r0 * 64 + wid * 32 + r32) * PITCH + C_QB + h * 128 + hi * 8;
                    tp.kp = PROJ + (size_t)(b * SEQ + i0 * 64) * PITCH + C_KB + h * 128;
                    tp.vp = PROJ + (size_t)(b * SEQ + i0 * 64) * PITCH + C_VB + h * 128;
                    tp.kstride = PITCH; tp.nt = i1 - i0 + 1; tp.jact_lo = rs_ - i0; tp.jact_hi = rs_ + 7 - i0;
                    tp.fa = 0.f; tp.slope = 0.f; tp.tb = (i0 - rq + 7) * 128 + 48 + 15 + 4 * hi - c; tp.ucs = 4 * hi - cs; tp.sh = shB;
                    f32x16 o[4]; float l_reg = 0.f;
#pragma unroll
                    for (int d = 0; d < 4; ++d) for (int r = 0; r < 16; ++r) o[d][r] = 0.f;
                    attn_tiles<1>(al, tp, o, l_reg, tid);
                    float rli[16]; row_bcast(al, wid, r32, hi, __builtin_amdgcn_rcpf(l_reg), rli);
                    const float* go = INP(13) + (size_t)l * 128;
#pragma unroll
                    for (int r = 0; r < 16; ++r) { float s = 0.f; float v[4];
#pragma unroll
                        for (int d = 0; d < 4; ++d) { v[d] = o[d][r] * rli[r]; s += v[d] * v[d]; }
                        s = half_sum(s); const float rs = __builtin_amdgcn_rsqf(s * (1.f / 128.f) + RMS_EPS);
                        bf16* orow = MIX + (size_t)(b * SEQ + r0 * 64 + wid * 32 + crow(r, hi)) * DM + 1024 + h * 128 + r32;
#pragma unroll
                        for (int d = 0; d < 4; ++d) orow[d * 32] = att::f2bf(v[d] * rs * go[d * 32 + r32]); }
                    __syncthreads();
#ifdef CV_FILL
                    CONVERT_FILL();
#endif
                }
            }
            if (ATT_EN & 4) {
                gu32* qhead = ctl + CW_Q + 64 * (2 * l + 1);
                volatile LAS unsigned* qslot = MISC + 16;
                unsigned nxt = 0u;
                if (tid == 0) nxt = __hip_atomic_fetch_add(qhead, 1u, RLX_AGENT);
                for (;;) {
                    if (tid == 0) qslot[0] = nxt;
                    __syncthreads();
                    const int uc = (int)qslot[0];
                    __syncthreads();
                    if (uc >= 1152) break;
                    if (tid == 0) nxt = __hip_atomic_fetch_add(qhead, 1u, RLX_AGENT);
                    asm volatile("" : "+v"(tid)); const int lane = tid & 63, r32 = lane & 31, hi = lane >> 5;
                    const int b = uc / 576, h = (uc / 48) % 12, x = uc % 48, gbr = x >> 4, idx = x & 15;
                    const int dil = gbr == 0 ? 1 : gbr == 1 ? 4 : 16, L = SEQ / dil;
                    const int rho = gbr == 0 ? 0 : gbr == 1 ? (idx >> 2) : idx, u0 = gbr == 0 ? idx * 256 : gbr == 1 ? (idx & 3) * 256 : 0;
                    const int jlo = (u0 == 0) ? 1 : 0, jhi = (u0 + 256 >= L) ? 4 : 5;
                    const int i_ = wid * 32 + r32;
                    TileParams tp;
                    tp.qrow = PROJ + (size_t)(b * SEQ + (u0 + i_) * dil + rho) * PITCH + C_QC + h * 128 + hi * 8;
                    const int uk0 = u0 - 64 + 64 * jlo;
                    tp.kp = PROJ + (size_t)(b * SEQ + uk0 * dil + rho) * PITCH + C_KC + h * 128;
                    tp.vp = PROJ + (size_t)(b * SEQ + uk0 * dil + rho) * PITCH + C_VC + h * 128;
                    tp.kstride = (size_t)PITCH * dil; tp.nt = jhi - jlo + 1; tp.jact_lo = (wid >> 1) - jlo; tp.jact_hi = (wid >> 1) + 2 - jlo;
                    tp.fa = (float)(i_ + 64 - 64 * jlo - 4 * hi); tp.slope = __builtin_amdgcn_exp2f((float)(h + 1) * (-8.0f / 12.0f)) * LOG2E * (float)dil; tp.tb = 0; tp.ucs = 0; tp.sh = shC;
                    f32x16 o[4]; float l_reg = 0.f;
#pragma unroll
                    for (int d = 0; d < 4; ++d) for (int r = 0; r < 16; ++r) o[d][r] = 0.f;
                    attn_tiles<2>(al, tp, o, l_reg, tid);
                    float rli[16]; row_bcast(al, wid, r32, hi, __builtin_amdgcn_rcpf(l_reg), rli);
                    bf16* cog = CO + (size_t)gbr * M * 1536;
#pragma unroll
                    for (int r = 0; r < 16; ++r) { bf16* orow = cog + (size_t)(b * SEQ + (u0 + wid * 32 + crow(r, hi)) * dil + rho) * 1536 + h * 128 + r32;
#pragma unroll
                        for (int d = 0; d < 4; ++d) orow[d * 32] = att::f2bf(o[d][r] * rli[r]); }
                    if (hi == 0) LSE[((size_t)gbr * M + b * SEQ + (u0 + i_) * dil + rho) * 12 + h] = __builtin_amdgcn_logf(l_reg);
                    __syncthreads();
#ifdef CV_FILL
                    CONVERT_FILL();
#endif
                }
            }
#ifdef CV_SUBSET
            if ((vcu % CV_SUBSET) == 0)
#endif
            while (convert_some(cvq, cv_first, cv_n, ap, ws, (LAS float*)(lds + RING_OFF + wave * 16640), tid & 63)) {}
        }
        SEAM(pb + 1);
        for (int rep_ = 0; rep_ < 1 + REP(3); ++rep_) if (EN(3) && IN(pb + 2)) { PHASE_TID(); PHASE_PTRS();
            const int hs = lane >> 4, sub = lane & 15;
            const float* go = INP(16) + (size_t)l * 128 + sub * 8;
            const f32x4 g0 = *(const GAS f32x4*)go, g1 = *(const GAS f32x4*)(go + 4);
            for (int it = gw; it < (M / 4) * 3; it += NGW) {
                const int rg = it / 3, ch = it - rg * 3, h = ch * 4 + hs;
                float ls[4][3]; v4u w[4][3];
#pragma unroll
                for (int q4 = 0; q4 < 4; ++q4)
#pragma unroll
                    for (int g = 0; g < 3; ++g) { const size_t row = (size_t)rg * 4 + q4; ls[q4][g] = LSE[((size_t)g * M + row) * 12 + h]; w[q4][g] = *(const GAS v4u*)(CO + ((size_t)g * M + row) * 1536 + h * 128 + sub * 8); }
#pragma unroll
                for (int q4 = 0; q4 < 4; ++q4) {
                    const float mx = fmaxf(ls[q4][0], fmaxf(ls[q4][1], ls[q4][2]));
                    float e[3], es = 0.f;
#pragma unroll
                    for (int g = 0; g < 3; ++g) { e[g] = __builtin_amdgcn_exp2f(ls[q4][g] - mx); es += e[g]; }
                    const float inv = __builtin_amdgcn_rcpf(es); float x[8];
#pragma unroll
                    for (int q = 0; q < 8; ++q) x[q] = 0.f;
#pragma unroll
                    for (int g = 0; g < 3; ++g) { const float wg = e[g] * inv; const unsigned ww[4] = {w[q4][g].x, w[q4][g].y, w[q4][g].z, w[q4][g].w};
#pragma unroll
                        for (int q = 0; q < 4; ++q) { x[2 * q] += wg * bflo(ww[q]); x[2 * q + 1] += wg * bfhi(ww[q]); } }
                    float s = 0.f;
#pragma unroll
                    for (int q = 0; q < 8; ++q) s += x[q] * x[q];
                    s += att::swz_xor<1>(s); s += att::swz_xor<2>(s); s += att::swz_xor<4>(s); s += att::swz_xor<8>(s);
                    const float rs = __builtin_amdgcn_rsqf(s * (1.f / 128.f) + RMS_EPS);
                    v4u o; o.x = pk2(x[0] * rs * g0.x, x[1] * rs * g0.y); o.y = pk2(x[2] * rs * g0.z, x[3] * rs * g0.w); o.z = pk2(x[4] * rs * g1.x, x[5] * rs * g1.y); o.w = pk2(x[6] * rs * g1.z, x[7] * rs * g1.w);
                    *(GAS v4u*)(MIX + ((size_t)rg * 4 + q4) * D + 2560 + h * 128 + sub * 8) = o; }
            }
        }
        SEAM(pb + 2);
        for (int rep_ = 0; rep_ < 1 + REP(4); ++rep_) if (EN(4) && IN(pb + 3)) { PHASE_TID(); PHASE_PTRS();
            pg8::Gemm g{MIX, W_OUT, M, D, D}; pg8::StaticOrder S; S.init(M, D, G, (int)blockIdx.x);
            constexpr bool xmix = (MIX_GU >> l) & 1; using ER = pg8::EpiRes<false, xmix ? GU_PITCH : 0, xmix ? GUK8 : 0>;
            ER E{X0, X1, nullptr, xmix ? ws + WS_H : nullptr, D, PSQ + (size_t)(2 * l) * M * 64, 1.0f};
            pg8::gemm_phase<ER, pg8::StaticOrder, true, true>(lds + RING_OFF, g, S, E);
        }
        SEAM(pb + 3);
        for (int rep_ = 0; rep_ < 1 + REP(5); ++rep_) if (EN(5) && IN(pb + 4)) { PHASE_TID(); PHASE_PTRS();
            constexpr int gmode = ((MIX_GU >> l) & 1) ? 2 : 0;
            pg8::Gemm g{gmode == 2 ? (const bf16*)(ws + WS_H) : X1, W_GU, M, 2 * FF, gmode == 2 ? GU_PITCH / 2 : D, gmode == 2 ? GU_T8 : 0}; pg8::StaticOrder S; S.init(M, 2 * FF, G, (int)blockIdx.x);
            const float* psrc = PSQ + (size_t)(2 * l) * M * 64;
            pg8::Unit u0; (void)S.next(0, u0); build_rstab(lds, psrc, 64, u0.pm, tid);
            if ((F8_DOWN >> l) & 1) { pg8::EpiSwiGLU<1> E{ACT, FF, FF, pg8::RowScale{(const LAS float*)(lds + RSTAB_OFF), u0.pm, psrc, 64}};
                pg8::gemm_phase<pg8::EpiSwiGLU<1>, pg8::StaticOrder, true, true, gmode>(lds + RING_OFF, g, S, E); }
            else if ((MIX_DOWN >> l) & 1) { pg8::EpiSwiGLU<2> E{ACT, MIX_PITCH, MIXK8, pg8::RowScale{(const LAS float*)(lds + RSTAB_OFF), u0.pm, psrc, 64}};
                pg8::gemm_phase<pg8::EpiSwiGLU<2>, pg8::StaticOrder, true, true, gmode>(lds + RING_OFF, g, S, E); }
            else { pg8::EpiSwiGLU<0> E{ACT, 2 * FF, 0, pg8::RowScale{(const LAS float*)(lds + RSTAB_OFF), u0.pm, psrc, 64}};
                pg8::gemm_phase<pg8::EpiSwiGLU<0>, pg8::StaticOrder, true, true, gmode>(lds + RING_OFF, g, S, E); }
        }
        SEAM(pb + 4);
        for (int rep_ = 0; rep_ < 1 + REP(6); ++rep_) if (EN(6) && IN(pb + 5)) { PHASE_TID(); PHASE_PTRS();
            constexpr int dmode = ((F8_DOWN >> l) & 1) ? 1 : ((MIX_DOWN >> l) & 1) ? 2 : 0;
            pg8::Gemm g{ACT, W_DN, M, D, dmode == 1 ? FF / 2 : dmode == 2 ? MIX_PITCH / 2 : FF, dmode == 2 ? MIX_T8 : 0}; pg8::StaticOrder S; S.init(M, D, G, (int)blockIdx.x);
            const float asc = dmode == 1 ? 1.0f / (16.0f * 64.0f) : 1.0f;
            if (l + 1 < NLAYER) { pg8::EpiRes<false> E{X1, X0, nullptr, nullptr, D, PSQ + (size_t)(2 * l + 1) * M * 64, asc};
                pg8::gemm_phase<pg8::EpiRes<false>, pg8::StaticOrder, true, true, dmode>(lds + RING_OFF, g, S, E); }
            else { pg8::EpiRes<true> E{X1, nullptr, xout, nullptr, D, nullptr, asc};
                pg8::gemm_phase<pg8::EpiRes<true>, pg8::StaticOrder, true, true, dmode>(lds + RING_OFF, g, S, E); }
        }
        SEAM(pb + 5);
    }
#undef IN
#undef SEAM
}

#ifndef MK_PER_PHASE
#define MK_PER_PHASE 0
#endif
extern "C" void kernel_launch(void* const* d_in, const int* in_sizes, int n_in, void* d_out, int out_size, void* d_ws, size_t ws_size, hipStream_t stream) {
    static int grid = 0;
    if (grid == 0) {
        if (n_in != NIN || in_sizes[0] != M * D || out_size != M * D || ws_size < WS_END) { fprintf(stderr, "kernel_launch: shape mismatch n_in %d in0 %d out %d ws %zu (need %zu)\n", n_in, n_in > 0 ? in_sizes[0] : -1, out_size, ws_size, (size_t)WS_END); grid = -1; return; }
        int dev = 0, cus = 0, per_cu = 0;
        if (hipGetDevice(&dev) != hipSuccess || hipDeviceGetAttribute(&cus, hipDeviceAttributeMultiprocessorCount, dev) != hipSuccess) { grid = -1; return; }
        if (hipFuncSetAttribute((const void*)mega_fwd, hipFuncAttributeMaxDynamicSharedMemorySize, LDS_BYTES) != hipSuccess) { fprintf(stderr, "kernel_launch: hipFuncSetAttribute failed\n"); grid = -1; return; }
        if (hipOccupancyMaxActiveBlocksPerMultiprocessor(&per_cu, (const void*)mega_fwd, NWAVES * 64, LDS_BYTES) != hipSuccess || per_cu < 1) fprintf(stderr, "kernel_launch: occupancy query reports %d\n", per_cu);
        (void)hipGetLastError();
        grid = cus;
    }
    if (grid < 0) return;
    if (hipMemsetAsync((char*)d_ws + WS_CTL, 0, CTL_ZERO_BYTES, stream) != hipSuccess) { fprintf(stderr, "kernel_launch: memset failed\n"); return; }
    Args a{};
    for (int i = 0; i < NIN; ++i) a.in[i] = (const float*)d_in[i];
    a.out = (float*)d_out; a.ws = (unsigned char*)d_ws;
#if MK_PER_PHASE
    for (int p = 0; p < NPHASE; ++p) { a.ph_lo = p; a.ph_hi = p + 1; hipLaunchKernelGGL(mega_fwd, dim3(grid), dim3(NWAVES * 64), LDS_BYTES, stream, a); }
#else
    a.ph_lo = 0; a.ph_hi = NPHASE; hipLaunchKernelGGL(mega_fwd, dim3(grid), dim3(NWAVES * 64), LDS_BYTES, stream, a);
#endif
    const hipError_t le = hipPeekAtLastError();
    if (le != hipSuccess) fprintf(stderr, "kernel_launch: launch failed: %s\n", hipGetErrorName(le));
}
```
